# Optimizing an MI355X kernel written in HIP

```python
import jax, jax.numpy as jnp
from jax import lax
import numpy as np

D_MODEL = 1024
BATCH = 4
SEQ = 4096
DEPTH = 1

PLE_DIM = 256
MLA_HEADS = 8
MLA_NOPE_DIM = 64
MLA_ROPE_DIM = 32
MLA_V_DIM = 64
Q_LORA_RANK = 384
KV_LORA_RANK = 256
SB_HEADS = 8
SB_HEAD_DIM = 64
MLA_WIDTH = MLA_HEADS * MLA_V_DIM
SB_WIDTH = SB_HEADS * SB_HEAD_DIM
MIX_WIDTH = MLA_WIDTH + SB_WIDTH
IN_SPLITS = (Q_LORA_RANK,
             Q_LORA_RANK + KV_LORA_RANK,
             Q_LORA_RANK + KV_LORA_RANK + MLA_ROPE_DIM,
             Q_LORA_RANK + KV_LORA_RANK + MLA_ROPE_DIM + SB_WIDTH,
             Q_LORA_RANK + KV_LORA_RANK + MLA_ROPE_DIM + 2 * SB_WIDTH)
IN_COLS = Q_LORA_RANK + KV_LORA_RANK + MLA_ROPE_DIM + 3 * SB_WIDTH
ROPE_THETA = 10000.0
Q_BLOCK = 128
N_EXPERTS = 32
TOP_K = 4
D_FF = 1024
SWIGLU_LIMIT = 7.0
SWIGLU_ALPHA = 1.702
EXPERT_BLOCK = 128
RMS_EPS = 1e-6
MAX_POS_OFFSET = 4096

kernel_name = "hybrid_mla_stickbreak_moe_ple"


def rmsnorm(x, g):
    xf = x.astype(jnp.float32)
    y = xf * lax.rsqrt(jnp.mean(xf * xf, axis=-1, keepdims=True) + RMS_EPS)
    return (y * g.astype(jnp.float32)).astype(x.dtype)


def rope_tables(positions):
    inv_freq = ROPE_THETA ** (-jnp.arange(0, MLA_ROPE_DIM, 2, dtype=jnp.float32) / MLA_ROPE_DIM)
    ang = positions.astype(jnp.float32)[..., None] * inv_freq
    return jnp.cos(ang), jnp.sin(ang)


def apply_rope(x, cos, sin):
    xf = x.astype(jnp.float32)
    x1, x2 = jnp.split(xf, 2, axis=-1)
    return jnp.concatenate([x1 * cos - x2 * sin, x2 * cos + x1 * sin], axis=-1).astype(x.dtype)


def to_blocks(a):
    b, h, s, d = a.shape
    return jnp.moveaxis(a.reshape(b, h, s // Q_BLOCK, Q_BLOCK, d), 2, 0)


def from_blocks(o):
    n, b, h, qb, d = o.shape
    return jnp.moveaxis(o, 0, 2).reshape(b, h, n * qb, d).transpose(0, 2, 1, 3).reshape(b, n * qb, h * d)


def mixer_heads(q_nope, q_rope, k_nope, k_rope, v_mla, q_sb, k_sb, v_sb):
    seq = k_nope.shape[2]
    n_blk = seq // Q_BLOCK
    key_pos = jnp.arange(seq)
    mla_scale = (MLA_NOPE_DIM + MLA_ROPE_DIM) ** -0.5
    sb_scale = SB_HEAD_DIM ** -0.5

    def block(args):
        bi, qn, qr, qs = args
        q_pos = bi * Q_BLOCK + jnp.arange(Q_BLOCK)
        s = (jnp.einsum('bhqd,bhkd->bhqk', qn, k_nope, preferred_element_type=jnp.float32)
             + jnp.einsum('bhqr,bkr->bhqk', qr, k_rope, preferred_element_type=jnp.float32)) * mla_scale
        causal = key_pos[None, :] <= q_pos[:, None]
        w = jax.nn.softmax(jnp.where(causal, s, -jnp.inf), axis=-1)
        o_m = jnp.einsum('bhqk,bhkd->bhqd', w.astype(v_mla.dtype), v_mla)
        z = jnp.einsum('bhqd,bhkd->bhqk', qs, k_sb, preferred_element_type=jnp.float32) * sb_scale
        strict = key_pos[None, :] < q_pos[:, None]
        log_not = jnp.where(strict, jax.nn.log_sigmoid(-z), 0.0)
        after = lax.cumsum(log_not, axis=3, reverse=True) - log_not
        log_a = jnp.where(strict, jax.nn.log_sigmoid(z) + after, -jnp.inf)
        o_s = jnp.einsum('bhqk,bhkd->bhqd', jnp.exp(log_a).astype(v_sb.dtype), v_sb)
        return o_m, o_s

    o_m, o_s = lax.map(block, (jnp.arange(n_blk), to_blocks(q_nope), to_blocks(q_rope), to_blocks(q_sb)))
    return from_blocks(o_m), from_blocks(o_s)


def moe(u, w_router, b_router, w_gu, b_gu, w_dn, b_dn):
    b, s, d = u.shape
    t = b * s
    xt = u.reshape(t, d)
    logits = jnp.dot(xt, w_router, preferred_element_type=jnp.float32) + b_router.astype(jnp.float32)
    top_logit, top_e = lax.top_k(logits, TOP_K)
    gate = jax.nn.softmax(top_logit, axis=-1)
    n_pairs = t * TOP_K
    flat_e = top_e.reshape(-1)
    flat_tok = jnp.arange(n_pairs, dtype=jnp.int32) // TOP_K
    flat_g = gate.reshape(-1)
    order = jnp.argsort(flat_e)
    sorted_e = flat_e[order]
    counts = jnp.bincount(flat_e, length=N_EXPERTS)
    padded = (counts + EXPERT_BLOCK - 1) // EXPERT_BLOCK * EXPERT_BLOCK
    pad_end = jnp.cumsum(padded)
    pad_start = pad_end - padded
    start = jnp.cumsum(counts) - counts
    dest = pad_start[sorted_e] + jnp.arange(n_pairs) - start[sorted_e]
    n_blocks = -(-n_pairs // EXPERT_BLOCK) + N_EXPERTS
    n_rows = n_blocks * EXPERT_BLOCK
    row_tok = jnp.full((n_rows,), t, jnp.int32).at[dest].set(flat_tok[order])
    row_gate = jnp.zeros((n_rows,), jnp.float32).at[dest].set(flat_g[order])
    block_e = jnp.minimum(jnp.searchsorted(pad_end, jnp.arange(n_blocks) * EXPERT_BLOCK, side='right'),
                          N_EXPERTS - 1)
    x_pad = jnp.concatenate([xt, jnp.zeros((1, d), xt.dtype)], axis=0)
    xb = x_pad[row_tok].reshape(n_blocks, EXPERT_BLOCK, d)

    def expert_block(args):
        e, xs = args
        hh = jnp.dot(xs, w_gu[e]) + b_gu[e]
        glu, lin = jnp.split(hh, 2, axis=-1)
        glu = jnp.minimum(glu, SWIGLU_LIMIT)
        lin = jnp.clip(lin, -SWIGLU_LIMIT, SWIGLU_LIMIT)
        act = glu * jax.nn.sigmoid(SWIGLU_ALPHA * glu) * (lin + 1.0)
        return jnp.dot(act, w_dn[e]) + b_dn[e]

    yb = lax.map(expert_block, (block_e, xb))
    yr = yb.reshape(n_rows, d) * row_gate[:, None].astype(yb.dtype)
    y = jax.ops.segment_sum(yr, row_tok, num_segments=t + 1)[:t]
    return y.reshape(b, s, d)


def setup_inputs(seed: int = 0) -> dict:
    key = jax.random.key(seed)
    ks = jax.random.split(key, 24)

    def nrm(k, shape, scale):
        return jax.random.normal(k, shape, jnp.float32) * scale

    def gain(k, shape):
        return 1.0 + 0.05 * jax.random.normal(k, shape, jnp.float32)

    offsets = jax.random.randint(ks[2], (BATCH, 1), 0, MAX_POS_OFFSET, dtype=jnp.int32)
    positions = offsets + jnp.arange(SEQ, dtype=jnp.int32)[None, :]
    return {
        'x': nrm(ks[0], (BATCH, SEQ, D_MODEL), 1.0),
        'p': nrm(ks[1], (DEPTH, BATCH, SEQ, PLE_DIM), 1.0),
        'positions': positions,
        'w_in': nrm(ks[3], (DEPTH, D_MODEL, IN_COLS), D_MODEL ** -0.5),
        'g_attn': gain(ks[4], (DEPTH, D_MODEL)),
        'g_cq': gain(ks[5], (DEPTH, Q_LORA_RANK)),
        'w_uq': nrm(ks[6], (DEPTH, Q_LORA_RANK, MLA_HEADS * (MLA_NOPE_DIM + MLA_ROPE_DIM)), Q_LORA_RANK ** -0.5),
        'g_ckv': gain(ks[7], (DEPTH, KV_LORA_RANK)),
        'w_ukv': nrm(ks[8], (DEPTH, KV_LORA_RANK, MLA_HEADS * (MLA_NOPE_DIM + MLA_V_DIM)), KV_LORA_RANK ** -0.5),
        'g_out_mla': gain(ks[9], (DEPTH, MLA_WIDTH)),
        'g_out_sb': gain(ks[10], (DEPTH, SB_WIDTH)),
        'w_o': nrm(ks[11], (DEPTH, MIX_WIDTH, D_MODEL), MIX_WIDTH ** -0.5),
        'g_moe': gain(ks[12], (DEPTH, D_MODEL)),
        'w_router': nrm(ks[13], (DEPTH, D_MODEL, N_EXPERTS), D_MODEL ** -0.5),
        'b_router': nrm(ks[14], (DEPTH, N_EXPERTS), 0.01),
        'w_gu': nrm(ks[15], (DEPTH, N_EXPERTS, D_MODEL, 2 * D_FF), D_MODEL ** -0.5),
        'b_gu': nrm(ks[16], (DEPTH, N_EXPERTS, 2 * D_FF), 0.01),
        'w_dn': nrm(ks[17], (DEPTH, N_EXPERTS, D_FF, D_MODEL), D_FF ** -0.5),
        'b_dn': nrm(ks[18], (DEPTH, N_EXPERTS, D_MODEL), 0.01),
        'g_ple': gain(ks[19], (DEPTH, D_MODEL)),
        'w_ple_gate': nrm(ks[20], (DEPTH, D_MODEL, D_MODEL), D_MODEL ** -0.5),
        'w_ple_proj': nrm(ks[21], (DEPTH, PLE_DIM, D_MODEL), PLE_DIM ** -0.5),
        'g_final': gain(ks[22], (D_MODEL,)),
    }


def reference(x, p, positions, w_in, g_attn, g_cq, w_uq, g_ckv, w_ukv, g_out_mla, g_out_sb, w_o,
              g_moe, w_router, b_router, w_gu, b_gu, w_dn, b_dn, g_ple, w_ple_gate, w_ple_proj, g_final):
    b, s, _ = x.shape
    cos, sin = rope_tables(positions)

    def heads_first(a):
        return jnp.swapaxes(a, 1, 2)

    h = x
    for i in range(DEPTH):
        u = rmsnorm(h, g_attn[i])
        c_q, c_kv, k_r, q_s, k_s, v_s = jnp.split(u @ w_in[i], IN_SPLITS, axis=-1)
        q = (rmsnorm(c_q, g_cq[i]) @ w_uq[i]).reshape(b, s, MLA_HEADS, MLA_NOPE_DIM + MLA_ROPE_DIM)
        kv = (rmsnorm(c_kv, g_ckv[i]) @ w_ukv[i]).reshape(b, s, MLA_HEADS, MLA_NOPE_DIM + MLA_V_DIM)
        q_nope = q[..., :MLA_NOPE_DIM]
        q_rope = apply_rope(q[..., MLA_NOPE_DIM:], cos[:, :, None, :], sin[:, :, None, :])
        k_nope = kv[..., :MLA_NOPE_DIM]
        v_m = kv[..., MLA_NOPE_DIM:]
        k_rope = apply_rope(k_r, cos, sin)
        sb_shape = (b, s, SB_HEADS, SB_HEAD_DIM)
        o_m, o_s = mixer_heads(heads_first(q_nope), heads_first(q_rope), heads_first(k_nope), k_rope,
                               heads_first(v_m), heads_first(q_s.reshape(sb_shape)),
                               heads_first(k_s.reshape(sb_shape)), heads_first(v_s.reshape(sb_shape)))
        mixed = jnp.concatenate([rmsnorm(o_m, g_out_mla[i]), rmsnorm(o_s, g_out_sb[i])], axis=-1)
        h = h + mixed @ w_o[i]
        h = h + moe(rmsnorm(h, g_moe[i]), w_router[i], b_router[i], w_gu[i], b_gu[i], w_dn[i], b_dn[i])
        u = rmsnorm(h, g_ple[i])
        h = h + jax.nn.sigmoid(u @ w_ple_gate[i]) * (p[i] @ w_ple_proj[i])
    return rmsnorm(h, g_final)
```

```cpp
#include <hip/hip_runtime.h>
#include <cstdio>
#include <cstdint>

#ifndef MK_ONE_LAUNCH
#define MK_ONE_LAUNCH 0
#endif

constexpr int BATCH = 4, SEQ = 4096, T = BATCH * SEQ, D = 1024;
constexpr int NIN = 2208, NINP = 2304;
constexpr int QLR = 384, KVLR = 256, ROPE = 32, NOPE = 64, VDIM = 64, HM = 8, HS = 8, SBD = 64, QKD = NOPE + ROPE;
constexpr int C_CQ = 0, C_CKV = 384, C_KR = 640, C_QS = 672, C_KS = 1184, C_VS = 1696;
constexpr int NE = 32, TOPK = 4, DFF = 1024, PLE = 256;
constexpr int RPAD = T * TOPK + NE * 256;
constexpr float EPS = 1e-6f;
constexpr float LOG2E = 1.4426950408889634f;
constexpr float Q_SCALE = 0.10206207261596577f * LOG2E;
constexpr float QS_SCALE = 0.125f * LOG2E;
constexpr float SB_DONE = -200.0f;

constexpr int NWAVES = 8, NTHR = NWAVES * 64;

constexpr size_t MiB = 1u << 20;
constexpr size_t WS_CTL = 0, CTL_ZERO_BYTES = 1 * MiB;
constexpr size_t WS_WIN = 1 * MiB, WS_WUQ = 6 * MiB, WS_WUKV = 7 * MiB, WS_WO = 8 * MiB, WS_WPG = 10 * MiB, WS_WPP = 12 * MiB;
constexpr size_t WS_ROUTE = 13 * MiB, WS_CS = 14 * MiB;
constexpr size_t WS_WGU = 16 * MiB, WS_WDN = 144 * MiB, WS_XN = 208 * MiB, WS_Y1 = 240 * MiB, WS_Q = 312 * MiB, WS_KN = 336 * MiB, WS_VM = 352 * MiB;
constexpr size_t WS_O = 368 * MiB, WS_H1 = 400 * MiB, WS_PBF = 464 * MiB, WS_PROJ = 472 * MiB, WS_XG = 504 * MiB, WS_ACT = 648 * MiB, WS_PARTA = 792 * MiB, WS_PARTO = 793 * MiB, WS_END = 794 * MiB;
constexpr int CW_TMO = 0, CW_CODE = 1, CW_BAR = 4096, CW_CNT = 8192, CW_SSQ = 16384;
constexpr int SSQ_CQ = 0, SSQ_CKV = 1, SSQ_OM = 2, SSQ_OS = 3, SSQ_FIN = 4;
static_assert((CW_SSQ + 5 * T) * 4 <= (int)CTL_ZERO_BYTES, "ctl");

constexpr int RING_OFF = 0, RING_BYTES = 131072;
constexpr int LDSCTL_OFF = RING_BYTES, MISC_OFF = LDSCTL_OFF + 320;
constexpr int L_TSTART = LDSCTL_OFF + 1024;
constexpr int L_LCNT = LDSCTL_OFF + 1280;
constexpr int L_RSCR = LDSCTL_OFF + 2048;
constexpr int LDS_BYTES = 147456;

#define GAS __attribute__((address_space(1)))
#define LAS __attribute__((address_space(3)))
typedef unsigned short bf16;
typedef unsigned v4u __attribute__((ext_vector_type(4)));
typedef unsigned v2u __attribute__((ext_vector_type(2)));
typedef float f32x4 __attribute__((ext_vector_type(4)));
typedef GAS unsigned gu32;
#define RLX_AGENT __ATOMIC_RELAXED, __HIP_MEMORY_SCOPE_AGENT

__device__ __forceinline__ unsigned f2bf(float f) { unsigned u = __builtin_bit_cast(unsigned, f); return (u + 0x7fffu + ((u >> 16) & 1u)) >> 16; }
__device__ __forceinline__ unsigned pk2(float lo, float hi) { return f2bf(lo) | (f2bf(hi) << 16); }
__device__ __forceinline__ float bflo(unsigned w) { return __uint_as_float(w << 16); }
__device__ __forceinline__ float bfhi(unsigned w) { return __uint_as_float(w & 0xffff0000u); }
__device__ __forceinline__ float bf2f(bf16 v) { return __uint_as_float((unsigned)v << 16); }
__device__ __forceinline__ float wave_sum(float v) {
#pragma unroll
    for (int o = 1; o < 64; o <<= 1) v += __shfl_xor(v, o);
    return v;
}

#define XB_TMO      128
#define XB_XCNT(j)  (256  + 64 * (j))
#define XB_XSUB(j)  (1280 + 64 * (j))
#define XB_XGEN(j)  (2304 + 64 * (j))
#define XB_TOP      3328
#define XB_TOPGEN   3392
#define XCD_BAR_WORDS 3456
#define XB_SPIN_CAP (1u << 18)
__device__ __forceinline__ unsigned xb_ld(unsigned* p)              { return __hip_atomic_load(p, __ATOMIC_RELAXED, __HIP_MEMORY_SCOPE_AGENT); }
__device__ __forceinline__ unsigned xb_add(unsigned* p, unsigned v) { return __hip_atomic_fetch_add(p, v, __ATOMIC_RELAXED, __HIP_MEMORY_SCOPE_AGENT); }
__device__ __forceinline__ unsigned xb_xcc_id() { return (unsigned)__builtin_amdgcn_s_getreg((3 << 11) | 20) & 0xFu; }
#define XB_SPIN(cond, bar) do { unsigned _sp = 0; while (cond) { __builtin_amdgcn_s_sleep(1); \
    if ((++_sp & 255u) == 0u) { if (xb_ld(&(bar)[XB_TMO])) break; if (_sp > XB_SPIN_CAP) { atomicAdd(&(bar)[XB_TMO], 1u); break; } } } } while (0)
struct XcdBarrier { unsigned* bar; unsigned x; volatile LAS unsigned* st; };
__device__ __forceinline__ XcdBarrier xcd_barrier_post(unsigned* bar, volatile LAS unsigned* st) {
    XcdBarrier b; b.bar = bar; b.x = xb_xcc_id(); b.st = st;
    if (threadIdx.x == 0) (void)xb_add(&bar[XB_XCNT(b.x)], 1u);
    return b;
}
__device__ __forceinline__ void xcd_barrier_complete(unsigned* bar, unsigned x, unsigned& nloc, unsigned& nx) {
    const unsigned G = gridDim.x * gridDim.y * gridDim.z;
    unsigned sum, cnt, mine, sp = 0u;
    for (;;) {
        sum = 0u; cnt = 0u; mine = 0u;
#pragma unroll
        for (unsigned j = 0; j < 16; ++j) { const unsigned c = xb_ld(&bar[XB_XCNT(j)]); sum += c; cnt += (c > 0u) ? 1u : 0u; mine = (j == x) ? c : mine; }
        if (sum == G) break;
        __builtin_amdgcn_s_sleep(1);
        if ((++sp & 255u) == 0u) { if (xb_ld(&bar[XB_TMO])) break; if (sp > XB_SPIN_CAP) { atomicAdd(&bar[XB_TMO], 1u); break; } }
    }
    nloc = mine > 0u ? mine : 1u; nx = cnt > 0u ? cnt : 1u;
}
__device__ __forceinline__ void xcd_barrier(const XcdBarrier& b) {
    asm volatile("s_waitcnt vmcnt(0)" ::: "memory");
    __syncthreads();
    if (threadIdx.x == 0) {
        unsigned* bar = b.bar;
        __builtin_amdgcn_s_waitcnt(0);
        unsigned nloc = b.st[0], nx = b.st[1];
        if (nloc == 0u) { xcd_barrier_complete(bar, b.x, nloc, nx); b.st[0] = nloc; b.st[1] = nx; }
        const unsigned old = xb_add(&bar[XB_XSUB(b.x)], 1u);
        const unsigned gen = old / nloc;
        if (old + 1u == (gen + 1u) * nloc) {
            __builtin_amdgcn_fence(__ATOMIC_RELEASE, "agent");
            asm volatile("s_waitcnt vmcnt(0)" ::: "memory");
            const unsigned og = xb_add(&bar[XB_TOP], 1u);
            const unsigned tg = og / nx;
            if (og + 1u == (tg + 1u) * nx) xb_add(&bar[XB_TOPGEN], 1u);
            else XB_SPIN(xb_ld(&bar[XB_TOPGEN]) == tg, bar);
            __builtin_amdgcn_fence(__ATOMIC_ACQUIRE, "agent");
            xb_add(&bar[XB_XGEN(b.x)], 1u);
            asm volatile("s_waitcnt vmcnt(0)" ::: "memory");
        } else {
            XB_SPIN(xb_ld(&bar[XB_XGEN(b.x)]) == gen, bar);
            __builtin_amdgcn_fence(__ATOMIC_ACQUIRE, "agent");
            asm volatile("s_waitcnt vmcnt(0)" ::: "memory");
        }
    }
    __syncthreads();
}

struct Frame {
    LAS unsigned char* lds;
    volatile LAS unsigned* MISC;
    gu32* ctl;
    float *PA, *PO;
    int tid, lane, wave, vcu, G;
    const float *x, *p; const int* pos;
    const float *w_in, *g_attn, *g_cq, *w_uq, *g_ckv, *w_ukv, *g_out_mla, *g_out_sb, *w_o, *g_moe, *w_router, *b_router, *w_gu, *b_gu, *w_dn, *b_dn, *g_ple, *w_ple_gate, *w_ple_proj, *g_final;
    float* out;
    bf16 *XN, *Y1, *Q, *KN, *VM, *O, *PBF, *PROJ, *XG, *ACT, *Yb;
    float *H1, *COS, *SIN;
    int *topk_e, *lpos, *slot; float* gate;
};

__device__ __forceinline__ void p0_prologue(Frame& F) {
    const int gw = F.vcu * NWAVES + F.wave, NGW = F.G * NWAVES;
    for (int m = gw; m < T; m += NGW) {
        const GAS f32x4* xr = (const GAS f32x4*)(F.x + (size_t)m * D) + F.lane;
        f32x4 v[4]; float s = 0.f;
#pragma unroll
        for (int j = 0; j < 4; ++j) { v[j] = xr[64 * j]; s += (v[j].x * v[j].x + v[j].y * v[j].y) + (v[j].z * v[j].z + v[j].w * v[j].w); }
        const float r = 1.0f / sqrtf(wave_sum(s) * (1.f / D) + EPS);
        GAS v2u* o8 = (GAS v2u*)(F.XN + (size_t)m * D) + F.lane;
#pragma unroll
        for (int j = 0; j < 4; ++j) { v2u w; w.x = pk2(v[j].x * r, v[j].y * r); w.y = pk2(v[j].z * r, v[j].w * r); o8[64 * j] = w; }
    }
    const int gt = blockIdx.x * NTHR + F.tid, NT = F.G * NTHR;
    for (int i = gt; i < T * PLE / 4; i += NT) { const f32x4 v = ((const GAS f32x4*)F.p)[i]; v2u w; w.x = pk2(v.x, v.y); w.y = pk2(v.z, v.w); ((GAS v2u*)F.PBF)[i] = w; }
    for (int i = gt; i < T * 16; i += NT) {
        const int m = i >> 4, f = i & 15;
        const float invf = exp2f(-(float)f * (13.287712379549449f / 16.0f));
        const float ang = (float)F.pos[m] * invf;
        double t = (double)ang * 0.15915494309189535; t -= __builtin_rint(t);
        const float fr = (float)t;
        F.COS[i] = __builtin_amdgcn_cosf(fr); F.SIN[i] = __builtin_amdgcn_sinf(fr);
    }
}

__device__ __forceinline__ float sum8(const float* p) { const f32x4 a = *(const GAS f32x4*)p, b = *(const GAS f32x4*)(p + 4); return ((a.x + a.y) + (a.z + a.w)) + ((b.x + b.y) + (b.z + b.w)); }
__device__ __forceinline__ void naive_rowssq(Frame& F) {
    const int gw = F.vcu * NWAVES + F.wave, NGW = F.G * NWAVES;
    for (int m = gw; m < T; m += NGW) {
        float sq = 0.f, skv = 0.f;
        for (int c = F.lane; c < C_KR; c += 64) { const float v = bf2f(F.Y1[(size_t)m * NINP + c]); if (c < C_CKV) sq += v * v; else skv += v * v; }
        sq = wave_sum(sq); skv = wave_sum(skv);
        if (F.lane < 16) F.PA[(size_t)m * 16 + F.lane] = (F.lane == 0) ? sq : (F.lane == 8) ? skv : 0.f;
    }
}
template <class Epi>
__device__ __forceinline__ void naive_gemm(Frame& F, const bf16* A, int lda, int M, const Epi& E) {
    const long total = (long)(M / 8) * E.nv;
    const long gt = (long)blockIdx.x * NTHR + F.tid, NT = (long)F.G * NTHR;
    for (long it = gt; it < total; it += NT) {
        const int j = (int)(it % E.nv), m0 = (int)(it / E.nv) * 8;
        const float* W; int ldw; const float *gk0, *gk1; int c0, c1, ka0, kb0, ka1, kb1;
        if (!E.setup(F, m0, j, W, ldw, gk0, gk1, c0, c1, ka0, kb0, ka1, kb1)) continue;
        float a0[8], a1[8];
#pragma unroll
        for (int r = 0; r < 8; ++r) { a0[r] = 0.f; a1[r] = 0.f; }
        const bf16* Ar = A + (size_t)m0 * lda;
        for (int k = ka0; k < kb0; k += 8) {
            v4u av[8];
#pragma unroll
            for (int r = 0; r < 8; ++r) av[r] = *(const GAS v4u*)(Ar + (size_t)r * lda + k);
#pragma unroll
            for (int kk = 0; kk < 8; ++kk) {
                const float w = W[(size_t)(k + kk) * ldw + c0] * (gk0 ? gk0[k + kk] : 1.f);
#pragma unroll
                for (int r = 0; r < 8; ++r) { const unsigned u = av[r][kk >> 1]; a0[r] += ((kk & 1) ? bfhi(u) : bflo(u)) * w; }
            }
        }
        for (int k = ka1; k < kb1; k += 8) {
            v4u av[8];
#pragma unroll
            for (int r = 0; r < 8; ++r) av[r] = *(const GAS v4u*)(Ar + (size_t)r * lda + k);
#pragma unroll
            for (int kk = 0; kk < 8; ++kk) {
                const float w = W[(size_t)(k + kk) * ldw + c1] * (gk1 ? gk1[k + kk] : 1.f);
#pragma unroll
                for (int r = 0; r < 8; ++r) { const unsigned u = av[r][kk >> 1]; a1[r] += ((kk & 1) ? bfhi(u) : bflo(u)) * w; }
            }
        }
        E.store(F, m0, j, a0, a1);
    }
}

__device__ __forceinline__ int expert_of_tile(Frame& F, int tile) {
    const volatile LAS int* ts = (const volatile LAS int*)(F.lds + L_TSTART);
    int e = -1;
    for (int i = 0; i < NE; ++i) if (tile >= ts[i] && tile < ts[i + 1]) e = i;
    return e;
}

struct NE_InProj {
    int nv;
    __device__ __forceinline__ bool setup(Frame& Fr, int m0, int j, const float*& W, int& ldw, const float*& gk0, const float*& gk1, int& c0, int& c1, int& ka0, int& kb0, int& ka1, int& kb1) const {
        if (j >= C_KR + 16 && j < C_QS) return false;
        W = Fr.w_in; ldw = NIN; gk0 = Fr.g_attn; gk1 = Fr.g_attn; c0 = j; c1 = j; ka0 = 0; kb0 = D; ka1 = 0; kb1 = 0;
        if (j >= C_KR && j < C_KR + 16) { c1 = j + 16; kb1 = D; }
        return true;
    }
    __device__ __forceinline__ void store(Frame& Fr, int m0, int j, const float* a0, const float* a1) const {
#pragma unroll
        for (int r = 0; r < 8; ++r) {
            const int m = m0 + r; bf16* y = Fr.Y1 + (size_t)m * NINP;
            if (j < C_KR) y[j] = (bf16)f2bf(a0[r]);
            else if (j < C_KR + 16) { const int i = j - C_KR; const float c = Fr.COS[m * 16 + i], s = Fr.SIN[m * 16 + i];
                y[C_KR + 2 * i] = (bf16)f2bf(a0[r] * c - a1[r] * s); y[C_KR + 2 * i + 1] = (bf16)f2bf(a1[r] * c + a0[r] * s); }
            else if (j < C_KS) y[j] = (bf16)f2bf(a0[r] * QS_SCALE);
            else y[j] = (bf16)f2bf(a0[r]);
        }
    }
};
struct NE_Q {
    int nv;
    __device__ __forceinline__ bool setup(Frame& Fr, int m0, int j, const float*& W, int& ldw, const float*& gk0, const float*& gk1, int& c0, int& c1, int& ka0, int& kb0, int& ka1, int& kb1) const {
        const int w = j % QKD; if (w >= NOPE + 16) return false;
        W = Fr.w_uq; ldw = HM * QKD; gk0 = Fr.g_cq; gk1 = Fr.g_cq; c0 = j; c1 = j; ka0 = 0; kb0 = QLR; ka1 = 0; kb1 = 0;
        if (w >= NOPE) { c1 = j + 16; kb1 = QLR; }
        return true;
    }
    __device__ __forceinline__ void store(Frame& Fr, int m0, int j, const float* a0, const float* a1) const {
        const int h = j / QKD, w = j % QKD;
#pragma unroll
        for (int r = 0; r < 8; ++r) {
            const int m = m0 + r; bf16* q = Fr.Q + (size_t)m * (HM * QKD) + h * QKD;
            const float rinv = 1.0f / sqrtf(sum8(Fr.PA + (size_t)m * 16) * (1.f / QLR) + EPS) * Q_SCALE;
            if (w < NOPE) q[w] = (bf16)f2bf(a0[r] * rinv);
            else { const int i = w - NOPE; const float c = Fr.COS[m * 16 + i], s = Fr.SIN[m * 16 + i]; const float x1 = a0[r] * rinv, x2 = a1[r] * rinv;
                q[NOPE + 2 * i] = (bf16)f2bf(x1 * c - x2 * s); q[NOPE + 2 * i + 1] = (bf16)f2bf(x2 * c + x1 * s); }
        }
    }
};
struct NE_KV {
    int nv;
    __device__ __forceinline__ bool setup(Frame& Fr, int m0, int j, const float*& W, int& ldw, const float*& gk0, const float*& gk1, int& c0, int& c1, int& ka0, int& kb0, int& ka1, int& kb1) const {
        W = Fr.w_ukv; ldw = HM * (NOPE + VDIM); gk0 = Fr.g_ckv; gk1 = nullptr; c0 = j; c1 = j; ka0 = 0; kb0 = KVLR; ka1 = 0; kb1 = 0; return true;
    }
    __device__ __forceinline__ void store(Frame& Fr, int m0, int j, const float* a0, const float* a1) const {
        const int h = j / 128, w = j % 128;
#pragma unroll
        for (int r = 0; r < 8; ++r) {
            const int m = m0 + r;
            const float rinv = 1.0f / sqrtf(sum8(Fr.PA + (size_t)m * 16 + 8) * (1.f / KVLR) + EPS);
            if (w < NOPE) Fr.KN[(size_t)m * 512 + h * 64 + w] = (bf16)f2bf(a0[r] * rinv);
            else Fr.VM[(size_t)m * 512 + h * 64 + (w - NOPE)] = (bf16)f2bf(a0[r] * rinv);
        }
    }
};
struct NE_Wo {
    int nv;
    __device__ __forceinline__ bool setup(Frame& Fr, int m0, int j, const float*& W, int& ldw, const float*& gk0, const float*& gk1, int& c0, int& c1, int& ka0, int& kb0, int& ka1, int& kb1) const {
        W = Fr.w_o; ldw = D; gk0 = Fr.g_out_mla; gk1 = Fr.g_out_sb - 512; c0 = j; c1 = j; ka0 = 0; kb0 = 512; ka1 = 512; kb1 = 1024; return true;
    }
    __device__ __forceinline__ void store(Frame& Fr, int m0, int j, const float* a0, const float* a1) const {
#pragma unroll
        for (int r = 0; r < 8; ++r) {
            const int m = m0 + r;
            const float rm = 1.0f / sqrtf(sum8(Fr.PO + (size_t)m * 16) * (1.f / 512) + EPS), rs = 1.0f / sqrtf(sum8(Fr.PO + (size_t)m * 16 + 8) * (1.f / 512) + EPS);
            Fr.H1[(size_t)m * D + j] = Fr.x[(size_t)m * D + j] + a0[r] * rm + a1[r] * rs;
        }
    }
};
struct NE_Gu {
    int nv;
    __device__ __forceinline__ bool setup(Frame& Fr, int m0, int j, const float*& W, int& ldw, const float*& gk0, const float*& gk1, int& c0, int& c1, int& ka0, int& kb0, int& ka1, int& kb1) const {
        const int e = expert_of_tile(Fr, m0 >> 8); if (e < 0) return false;
        W = Fr.w_gu + (size_t)e * D * 2 * DFF; ldw = 2 * DFF; gk0 = Fr.g_moe; gk1 = Fr.g_moe; c0 = j; c1 = DFF + j; ka0 = 0; kb0 = D; ka1 = 0; kb1 = D; return true;
    }
    __device__ __forceinline__ void store(Frame& Fr, int m0, int j, const float* a0, const float* a1) const {
        const int e = expert_of_tile(Fr, m0 >> 8);
        const float bg = Fr.b_gu[e * 2 * DFF + j], bl = Fr.b_gu[e * 2 * DFF + DFF + j];
#pragma unroll
        for (int r = 0; r < 8; ++r) {
            float g = fminf(a0[r] + bg, 7.0f), l = fminf(fmaxf(a1[r] + bl, -7.0f), 7.0f);
            const float act = g * (1.0f / (1.0f + __expf(-1.702f * g))) * (l + 1.0f);
            Fr.ACT[(size_t)(m0 + r) * DFF + j] = (bf16)f2bf(act);
        }
    }
};
struct NE_Dn {
    int nv;
    __device__ __forceinline__ bool setup(Frame& Fr, int m0, int j, const float*& W, int& ldw, const float*& gk0, const float*& gk1, int& c0, int& c1, int& ka0, int& kb0, int& ka1, int& kb1) const {
        const int e = expert_of_tile(Fr, m0 >> 8); if (e < 0) return false;
        W = Fr.w_dn + (size_t)e * DFF * D; ldw = D; gk0 = nullptr; gk1 = nullptr; c0 = j; c1 = j; ka0 = 0; kb0 = DFF; ka1 = 0; kb1 = 0; return true;
    }
    __device__ __forceinline__ void store(Frame& Fr, int m0, int j, const float* a0, const float* a1) const {
        const int e = expert_of_tile(Fr, m0 >> 8);
        const float b = Fr.b_dn[e * D + j];
#pragma unroll
        for (int r = 0; r < 8; ++r) Fr.Yb[(size_t)(m0 + r) * D + j] = (bf16)f2bf(a0[r] + b);
    }
};
struct NE_Proj {
    int nv;
    __device__ __forceinline__ bool setup(Frame& Fr, int m0, int j, const float*& W, int& ldw, const float*& gk0, const float*& gk1, int& c0, int& c1, int& ka0, int& kb0, int& ka1, int& kb1) const {
        W = Fr.w_ple_proj; ldw = D; gk0 = nullptr; gk1 = nullptr; c0 = j; c1 = j; ka0 = 0; kb0 = PLE; ka1 = 0; kb1 = 0; return true;
    }
    __device__ __forceinline__ void store(Frame& Fr, int m0, int j, const float* a0, const float* a1) const {
#pragma unroll
        for (int r = 0; r < 8; ++r) Fr.PROJ[(size_t)(m0 + r) * D + j] = (bf16)f2bf(a0[r]);
    }
};
struct NE_Gate {
    int nv;
    __device__ __forceinline__ bool setup(Frame& Fr, int m0, int j, const float*& W, int& ldw, const float*& gk0, const float*& gk1, int& c0, int& c1, int& ka0, int& kb0, int& ka1, int& kb1) const {
        W = Fr.w_ple_gate; ldw = D; gk0 = Fr.g_ple; gk1 = nullptr; c0 = j; c1 = j; ka0 = 0; kb0 = D; ka1 = 0; kb1 = 0; return true;
    }
    __device__ __forceinline__ void store(Frame& Fr, int m0, int j, const float* a0, const float* a1) const {
#pragma unroll
        for (int r = 0; r < 8; ++r) {
            const int m = m0 + r;
            const float h3 = Fr.H1[(size_t)m * D + j] + (1.0f / (1.0f + __expf(-a0[r]))) * bf2f(Fr.PROJ[(size_t)m * D + j]);
            Fr.out[(size_t)m * D + j] = h3;
        }
    }
};

__device__ __forceinline__ void naive_attention(Frame& F) {
    const long gt = (long)blockIdx.x * NTHR + F.tid, NT = (long)F.G * NTHR;
    const long total = 2L * T * 8;
    for (long it = gt; it < total; it += NT) {
        const int tl = (int)(it & 63); long r = it >> 6;
        const int h = (int)(r & 7); r >>= 3; const int grp = (int)(r & 1); r >>= 1; const int b = (int)(r & 3); r >>= 2; const int tc = (int)r;
        const int t = tc * 64 + tl; const int m = b * SEQ + t;
        float o[64];
#pragma unroll
        for (int d = 0; d < 64; ++d) o[d] = 0.f;
        if (grp == 0) {
            unsigned q[48];
            const GAS v4u* qp = (const GAS v4u*)(F.Q + (size_t)m * (HM * QKD) + h * QKD);
#pragma unroll
            for (int c = 0; c < 12; ++c) { const v4u v = qp[c]; q[4 * c] = v.x; q[4 * c + 1] = v.y; q[4 * c + 2] = v.z; q[4 * c + 3] = v.w; }
            float mx = -1e30f, l = 0.f;
            for (int s = 0; s <= t; ++s) {
                const int ms = b * SEQ + s;
                const GAS v4u* kp = (const GAS v4u*)(F.KN + (size_t)ms * 512 + h * 64);
                const GAS v4u* kr = (const GAS v4u*)(F.Y1 + (size_t)ms * NINP + C_KR);
                float sc = 0.f;
#pragma unroll
                for (int c = 0; c < 12; ++c) { const v4u kv = (c < 8) ? kp[c] : kr[c - 8];
#pragma unroll
                    for (int i = 0; i < 4; ++i) sc += bflo(q[4 * c + i]) * bflo(kv[i]) + bfhi(q[4 * c + i]) * bfhi(kv[i]); }
                const float mn = fmaxf(mx, sc), al = exp2f(mx - mn), pp = exp2f(sc - mn);
                l = l * al + pp; mx = mn;
                const GAS v4u* vp = (const GAS v4u*)(F.VM + (size_t)ms * 512 + h * 64);
#pragma unroll
                for (int c = 0; c < 8; ++c) { const v4u vv = vp[c];
#pragma unroll
                    for (int i = 0; i < 4; ++i) { o[8 * c + 2 * i] = o[8 * c + 2 * i] * al + pp * bflo(vv[i]); o[8 * c + 2 * i + 1] = o[8 * c + 2 * i + 1] * al + pp * bfhi(vv[i]); } }
            }
            const float rl = 1.0f / l;
#pragma unroll
            for (int d = 0; d < 64; ++d) o[d] *= rl;
        } else {
            unsigned q[32];
            const GAS v4u* qp = (const GAS v4u*)(F.Y1 + (size_t)m * NINP + C_QS + h * 64);
#pragma unroll
            for (int c = 0; c < 8; ++c) { const v4u v = qp[c]; q[4 * c] = v.x; q[4 * c + 1] = v.y; q[4 * c + 2] = v.z; q[4 * c + 3] = v.w; }
            float run = 0.f;
            for (int s = t - 1; s >= 0; --s) {
                if (run < SB_DONE) break;
                const int ms = b * SEQ + s;
                const GAS v4u* kp = (const GAS v4u*)(F.Y1 + (size_t)ms * NINP + C_KS + h * 64);
                float z = 0.f;
#pragma unroll
                for (int c = 0; c < 8; ++c) { const v4u kv = kp[c];
#pragma unroll
                    for (int i = 0; i < 4; ++i) z += bflo(q[4 * c + i]) * bflo(kv[i]) + bfhi(q[4 * c + i]) * bfhi(kv[i]); }
                const float sp = fmaxf(z, 0.f) + log2f(1.0f + exp2f(-fabsf(z)));
                const float a = exp2f(z - sp + run);
                run -= sp;
                const GAS v4u* vp = (const GAS v4u*)(F.Y1 + (size_t)ms * NINP + C_VS + h * 64);
#pragma unroll
                for (int c = 0; c < 8; ++c) { const v4u vv = vp[c];
#pragma unroll
                    for (int i = 0; i < 4; ++i) { o[8 * c + 2 * i] += a * bflo(vv[i]); o[8 * c + 2 * i + 1] += a * bfhi(vv[i]); } }
            }
        }
        float ss = 0.f;
        GAS v4u* op = (GAS v4u*)(F.O + (size_t)m * D + grp * 512 + h * 64);
#pragma unroll
        for (int c = 0; c < 8; ++c) { v4u w;
#pragma unroll
            for (int i = 0; i < 4; ++i) { w[i] = pk2(o[8 * c + 2 * i], o[8 * c + 2 * i + 1]); ss += o[8 * c + 2 * i] * o[8 * c + 2 * i] + o[8 * c + 2 * i + 1] * o[8 * c + 2 * i + 1]; }
            op[c] = w; }
        F.PO[(size_t)m * 16 + grp * 8 + h] = ss;
    }
}

__device__ __forceinline__ void p5a_route(Frame& F) {
    LAS float* WR = (LAS float*)(F.lds + RING_OFF);
    for (int i = F.tid; i < D * NE / 4; i += NTHR) {
        const f32x4 v = ((const GAS f32x4*)F.w_router)[i]; const int k = (4 * i) / NE, e0 = (4 * i) % NE; const float g = F.g_moe[k];
        WR[(e0 + 0) * D + k] = v.x * g; WR[(e0 + 1) * D + k] = v.y * g; WR[(e0 + 2) * D + k] = v.z * g; WR[(e0 + 3) * D + k] = v.w * g;
    }
    volatile LAS unsigned* lcnt = (volatile LAS unsigned*)(F.lds + L_LCNT);
    LAS unsigned* rscr = (LAS unsigned*)(F.lds + L_RSCR) + F.wave * 64;
    if (F.tid < 64) lcnt[F.tid] = 0u;
    __syncthreads();
    const int gw = F.vcu * NWAVES + F.wave, NGW = F.G * NWAVES;
    const int lane = F.lane;
    const int myexp = ((lane & 1) << 4) | ((lane & 2) << 2) | (lane & 4) | ((lane & 8) >> 2) | ((lane & 16) >> 4);
    const float mybias = F.b_router[myexp];
    int ri = 0;
    for (int m = gw; m < T; m += NGW, ++ri) {
        const GAS f32x4* xr = (const GAS f32x4*)(F.H1 + (size_t)m * D) + lane;
        f32x4 v[4]; float s = 0.f;
#pragma unroll
        for (int j = 0; j < 4; ++j) { v[j] = xr[64 * j]; s += (v[j].x * v[j].x + v[j].y * v[j].y) + (v[j].z * v[j].z + v[j].w * v[j].w); }
        const float r = 1.0f / sqrtf(wave_sum(s) * (1.f / D) + EPS);
        GAS v2u* o8 = (GAS v2u*)(F.XN + (size_t)m * D) + lane;
#pragma unroll
        for (int j = 0; j < 4; ++j) { v[j] = v[j] * r; v2u w; w.x = pk2(v[j].x, v[j].y); w.y = pk2(v[j].z, v[j].w); o8[64 * j] = w; }
        float a[32];
#pragma unroll
        for (int e = 0; e < 32; ++e) {
            float acc = 0.f;
#pragma unroll
            for (int j = 0; j < 4; ++j) { const f32x4 w = *(const LAS f32x4*)(WR + e * D + 256 * j + 4 * lane); acc += (v[j].x * w.x + v[j].y * w.y) + (v[j].z * w.z + v[j].w * w.w); }
            a[e] = acc;
            if ((e & 1) == 1) __builtin_amdgcn_sched_barrier(0);
        }
#pragma unroll
        for (int st = 0; st < 5; ++st) {
            const int hh = 16 >> st; const bool up = (lane >> st) & 1;
#pragma unroll
            for (int i = 0; i < hh; ++i) { const float send = up ? a[i] : a[hh + i]; const float recv = __shfl_xor(send, 1 << st); a[i] = (up ? a[hh + i] : a[i]) + recv; }
        }
        float val = a[0] + __shfl_xor(a[0], 32) + mybias;
        int tv_i[4]; float tv_v[4];
#pragma unroll
        for (int k = 0; k < 4; ++k) {
            float bv = val; int bi = myexp;
#pragma unroll
            for (int off = 1; off < 32; off <<= 1) { const float ov = __shfl_xor(bv, off); const int oi = __shfl_xor(bi, off); if (ov > bv || (ov == bv && oi < bi)) { bv = ov; bi = oi; } }
            tv_v[k] = bv; tv_i[k] = bi; if (myexp == bi) val = -INFINITY;
        }
        float g[4], gs = 0.f;
#pragma unroll
        for (int k = 0; k < 4; ++k) { g[k] = __expf(tv_v[k] - tv_v[0]); gs += g[k]; }
        const float rg = 1.0f / gs;
        if (lane == 0) {
#pragma unroll
            for (int k = 0; k < 4; ++k) {
                const unsigned pos = __hip_atomic_fetch_add((LAS unsigned*)(F.lds + L_LCNT) + tv_i[k], 1u, __ATOMIC_RELAXED, __HIP_MEMORY_SCOPE_WORKGROUP);
                F.topk_e[m * 4 + k] = tv_i[k]; F.gate[m * 4 + k] = g[k] * rg;
                if (ri < 8) { rscr[ri * 8 + k] = (unsigned)tv_i[k]; rscr[ri * 8 + 4 + k] = pos; }
            }
        }
    }
    __syncthreads();
    if (F.tid < 32) lcnt[32 + F.tid] = __hip_atomic_fetch_add((unsigned*)(F.ctl + CW_CNT) + F.tid, lcnt[F.tid], RLX_AGENT);
    __syncthreads();
    ri = 0;
    for (int m = gw; m < T; m += NGW, ++ri) if (lane < 4 && ri < 8) F.lpos[m * 4 + lane] = (int)(rscr[ri * 8 + 4 + lane] + lcnt[32 + rscr[ri * 8 + lane]]);
}
__device__ __forceinline__ void build_tstart(Frame& F) {
    volatile LAS int* ts = (volatile LAS int*)(F.lds + L_TSTART);
    if (F.tid == 0) { int acc = 0; for (int e = 0; e < NE; ++e) { ts[e] = acc; const unsigned c = __hip_atomic_load((unsigned*)(F.ctl + CW_CNT) + e, RLX_AGENT); acc += (int)((c + 255u) >> 8); } ts[NE] = acc; ts[40] = acc; }
    __syncthreads();
}
__device__ __forceinline__ void p5b_gather(Frame& F) {
    build_tstart(F);
    const volatile LAS int* ts = (const volatile LAS int*)(F.lds + L_TSTART);
    const int gw = F.vcu * NWAVES + F.wave, NGW = F.G * NWAVES;
    for (int m = gw; m < T; m += NGW) {
        const GAS v4u* src = (const GAS v4u*)(F.XN + (size_t)m * D) + F.lane;
        const v4u a = src[0], b = src[64];
#pragma unroll
        for (int k = 0; k < 4; ++k) {
            const int e = F.topk_e[m * 4 + k]; const int sl = ts[e] * 256 + F.lpos[m * 4 + k];
            if (F.lane == 0) F.slot[m * 4 + k] = sl;
            GAS v4u* dst = (GAS v4u*)(F.XG + (size_t)sl * D) + F.lane; dst[0] = a; dst[64] = b;
        }
    }
}
__device__ __forceinline__ void p8_combine(Frame& F) {
    const int gw = F.vcu * NWAVES + F.wave, NGW = F.G * NWAVES; const int lane = F.lane;
    for (int m = gw; m < T; m += NGW) {
        int sl[4]; float g[4];
#pragma unroll
        for (int k = 0; k < 4; ++k) { sl[k] = F.slot[m * 4 + k]; g[k] = F.gate[m * 4 + k]; }
        f32x4 h[2][2]; float s = 0.f;
#pragma unroll
        for (int j = 0; j < 2; ++j) {
            GAS f32x4* hp = (GAS f32x4*)(F.H1 + (size_t)m * D + 512 * j + 8 * lane);
            h[j][0] = hp[0]; h[j][1] = hp[1];
#pragma unroll
            for (int k = 0; k < 4; ++k) {
                const v4u y = *(const GAS v4u*)(F.Yb + (size_t)sl[k] * D + 512 * j + 8 * lane);
                h[j][0].x += g[k] * bflo(y.x); h[j][0].y += g[k] * bfhi(y.x); h[j][0].z += g[k] * bflo(y.y); h[j][0].w += g[k] * bfhi(y.y);
                h[j][1].x += g[k] * bflo(y.z); h[j][1].y += g[k] * bfhi(y.z); h[j][1].z += g[k] * bflo(y.w); h[j][1].w += g[k] * bfhi(y.w);
            }
            hp[0] = h[j][0]; hp[1] = h[j][1];
#pragma unroll
            for (int i = 0; i < 2; ++i) s += (h[j][i].x * h[j][i].x + h[j][i].y * h[j][i].y) + (h[j][i].z * h[j][i].z + h[j][i].w * h[j][i].w);
        }
        const float r = 1.0f / sqrtf(wave_sum(s) * (1.f / D) + EPS);
#pragma unroll
        for (int j = 0; j < 2; ++j) { v4u w; w.x = pk2(h[j][0].x * r, h[j][0].y * r); w.y = pk2(h[j][0].z * r, h[j][0].w * r); w.z = pk2(h[j][1].x * r, h[j][1].y * r); w.w = pk2(h[j][1].z * r, h[j][1].w * r);
            *(GAS v4u*)(F.XN + (size_t)m * D + 512 * j + 8 * lane) = w; }
    }
}
__device__ __forceinline__ void p10_final(Frame& F) {
    const int gw = F.vcu * NWAVES + F.wave, NGW = F.G * NWAVES; const int lane = F.lane;
    for (int m = gw; m < T; m += NGW) {
        GAS f32x4* op = (GAS f32x4*)(F.out + (size_t)m * D) + lane;
        f32x4 v[4]; float s = 0.f;
#pragma unroll
        for (int j = 0; j < 4; ++j) { v[j] = op[64 * j]; s += (v[j].x * v[j].x + v[j].y * v[j].y) + (v[j].z * v[j].z + v[j].w * v[j].w); }
        const float r = 1.0f / sqrtf(wave_sum(s) * (1.f / D) + EPS);
#pragma unroll
        for (int j = 0; j < 4; ++j) { const f32x4 g = ((const GAS f32x4*)F.g_final)[64 * j + lane]; op[64 * j] = v[j] * r * g; }
    }
}

constexpr int N_PHASES = 13;
struct Args { const void* in[23]; float* out; unsigned char* ws; int ph_lo, ph_hi; };
__global__ void __launch_bounds__(NTHR, 2) mega_fwd(Args args) {
    extern __shared__ __attribute__((aligned(16))) unsigned char lds[];
    Frame F;
    F.lds = (LAS unsigned char*)lds;
    F.MISC = (volatile LAS unsigned*)(F.lds + MISC_OFF);
    F.tid = threadIdx.x; F.lane = F.tid & 63; F.wave = __builtin_amdgcn_readfirstlane(F.tid >> 6);
    F.G = gridDim.x; { const int bx = blockIdx.x; F.vcu = (F.G % 8 == 0) ? (bx % 8) * (F.G / 8) + bx / 8 : bx; }
    unsigned char* ws = args.ws;
    F.ctl = (gu32*)(ws + WS_CTL); F.PA = (float*)(ws + WS_PARTA); F.PO = (float*)(ws + WS_PARTO);
    F.x = (const float*)args.in[0]; F.p = (const float*)args.in[1]; F.pos = (const int*)args.in[2];
    F.w_in = (const float*)args.in[3]; F.g_attn = (const float*)args.in[4]; F.g_cq = (const float*)args.in[5]; F.w_uq = (const float*)args.in[6]; F.g_ckv = (const float*)args.in[7];
    F.w_ukv = (const float*)args.in[8]; F.g_out_mla = (const float*)args.in[9]; F.g_out_sb = (const float*)args.in[10]; F.w_o = (const float*)args.in[11]; F.g_moe = (const float*)args.in[12];
    F.w_router = (const float*)args.in[13]; F.b_router = (const float*)args.in[14]; F.w_gu = (const float*)args.in[15]; F.b_gu = (const float*)args.in[16]; F.w_dn = (const float*)args.in[17];
    F.b_dn = (const float*)args.in[18]; F.g_ple = (const float*)args.in[19]; F.w_ple_gate = (const float*)args.in[20]; F.w_ple_proj = (const float*)args.in[21]; F.g_final = (const float*)args.in[22];
    F.out = args.out;
    F.XN = (bf16*)(ws + WS_XN); F.Y1 = (bf16*)(ws + WS_Y1); F.Q = (bf16*)(ws + WS_Q); F.KN = (bf16*)(ws + WS_KN); F.VM = (bf16*)(ws + WS_VM); F.O = (bf16*)(ws + WS_O);
    F.PBF = (bf16*)(ws + WS_PBF); F.PROJ = (bf16*)(ws + WS_PROJ); F.XG = (bf16*)(ws + WS_XG); F.ACT = (bf16*)(ws + WS_ACT); F.Yb = (bf16*)(ws + WS_XG);
    F.H1 = (float*)(ws + WS_H1); F.COS = (float*)(ws + WS_CS); F.SIN = (float*)(ws + WS_CS + MiB);
    F.topk_e = (int*)(ws + WS_ROUTE); F.gate = (float*)(ws + WS_ROUTE + 256 * 1024); F.lpos = (int*)(ws + WS_ROUTE + 512 * 1024); F.slot = (int*)(ws + WS_ROUTE + 768 * 1024);
    for (int u = F.tid; u < (LDS_BYTES - LDSCTL_OFF) / 4; u += NTHR) ((LAS unsigned*)(F.lds + LDSCTL_OFF))[u] = 0u;
    __syncthreads();
    const int lo = args.ph_lo, hi = args.ph_hi;
    const bool one = (hi - lo) > 1;
    XcdBarrier bar; bar.bar = (unsigned*)(F.ctl + CW_BAR); bar.x = 0; bar.st = nullptr;
    if (one) bar = xcd_barrier_post((unsigned*)(F.ctl + CW_BAR), F.MISC + 8);
#define IN(k) (lo <= (k) && (k) < hi)
#define SEAM(k) do { if (IN(k) && IN((k) + 1)) xcd_barrier(bar); } while (0)
    if (IN(0)) { p0_prologue(F); } SEAM(0);
    if (IN(1)) { NE_InProj E{NIN}; naive_gemm(F, F.XN, D, T, E); NE_Proj E2{D}; naive_gemm(F, F.PBF, PLE, T, E2); } SEAM(1);
    if (IN(2)) { naive_rowssq(F); } SEAM(2);
    if (IN(3)) { NE_Q E{HM * QKD}; naive_gemm(F, F.Y1 + C_CQ, NINP, T, E); NE_KV E2{HM * 128}; naive_gemm(F, F.Y1 + C_CKV, NINP, T, E2); } SEAM(3);
    if (IN(4)) { naive_attention(F); } SEAM(4);
    if (IN(5)) { NE_Wo E{D}; naive_gemm(F, F.O, D, T, E); } SEAM(5);
    if (IN(6)) { p5a_route(F); } SEAM(6);
    if (IN(7)) { p5b_gather(F); } SEAM(7);
    if (IN(8)) { if (!IN(7)) build_tstart(F); NE_Gu E{DFF}; naive_gemm(F, F.XG, D, RPAD, E); } SEAM(8);
    if (IN(9)) { if (!IN(7)) build_tstart(F); NE_Dn E{D}; naive_gemm(F, F.ACT, DFF, RPAD, E); } SEAM(9);
    if (IN(10)) { p8_combine(F); } SEAM(10);
    if (IN(11)) { NE_Gate E{D}; naive_gemm(F, F.XN, D, T, E); } SEAM(11);
    if (IN(12)) { p10_final(F); }
#undef IN
#undef SEAM
}

extern "C" void kernel_launch(void* const* d_in, const int* in_sizes, int n_in, void* d_out, int out_size, void* d_ws, size_t ws_size, hipStream_t stream) {
    static int grid = 0;
    if (grid == 0) {
        if (n_in != 23 || in_sizes[0] != T * D || out_size != T * D || ws_size < WS_END) { fprintf(stderr, "kernel_launch: unexpected shapes (n_in %d, in0 %d, out %d, ws %zu); nothing launched\n", n_in, n_in > 0 ? in_sizes[0] : -1, out_size, ws_size); grid = -1; return; }
        int dev = 0, cus = 0;
        if (hipGetDevice(&dev) != hipSuccess || hipDeviceGetAttribute(&cus, hipDeviceAttributeMultiprocessorCount, dev) != hipSuccess) { grid = -1; return; }
        if (hipFuncSetAttribute((const void*)mega_fwd, hipFuncAttributeMaxDynamicSharedMemorySize, LDS_BYTES) != hipSuccess) { fprintf(stderr, "kernel_launch: hipFuncSetAttribute failed\n"); grid = -1; return; }
        int per_cu = 0;
        if (hipOccupancyMaxActiveBlocksPerMultiprocessor(&per_cu, (const void*)mega_fwd, NTHR, LDS_BYTES) != hipSuccess || per_cu < 1) fprintf(stderr, "kernel_launch: occupancy query reports %d\n", per_cu);
        (void)hipGetLastError();
        grid = cus;
        if (grid != 256) fprintf(stderr, "kernel_launch: %d CUs (expected 256)\n", grid);
    }
    if (grid < 0) return;
    (void)hipMemsetAsync((char*)d_ws + WS_CTL, 0, CTL_ZERO_BYTES, stream);
    Args a{};
    for (int i = 0; i < 23; ++i) a.in[i] = d_in[i];
    a.out = (float*)d_out; a.ws = (unsigned char*)d_ws;
#if MK_ONE_LAUNCH
    a.ph_lo = 0; a.ph_hi = N_PHASES;
    hipLaunchKernelGGL(mega_fwd, dim3(grid), dim3(NTHR), LDS_BYTES, stream, a);
#else
    for (int ph = 0; ph < N_PHASES; ++ph) { a.ph_lo = ph; a.ph_hi = ph + 1; hipLaunchKernelGGL(mega_fwd, dim3(grid), dim3(NTHR), LDS_BYTES, stream, a); }
#endif
}
```

```cpp
#include <hip/hip_runtime.h>
#include <cstdio>
#include <cstdint>

#ifndef MK_ONE_LAUNCH
#define MK_ONE_LAUNCH 1
#endif
#define OPT_P1 1
#define OPT_P3 1
#define OPT_P4 1
#define OPT_P5 1
#define OPT_P8 1
#define OPT_P9 1
#define OPT_P11 1

constexpr int BATCH = 4, SEQ = 4096, T = BATCH * SEQ, D = 1024;
constexpr int NIN = 2208, NINP = 2304;
constexpr int QLR = 384, KVLR = 256, ROPE = 32, NOPE = 64, VDIM = 64, HM = 8, HS = 8, SBD = 64, QKD = NOPE + ROPE;
constexpr int C_CQ = 0, C_CKV = 384, C_KR = 640, C_QS = 672, C_KS = 1184, C_VS = 1696;
constexpr int NE = 32, TOPK = 4, DFF = 1024, PLE = 256;
constexpr int RPAD = T * TOPK + NE * 256;
constexpr float EPS = 1e-6f;
constexpr float LOG2E = 1.4426950408889634f;
constexpr float Q_SCALE = 0.10206207261596577f * LOG2E;
constexpr float QS_SCALE = 0.125f * LOG2E;
constexpr float SB_DONE = -200.0f;

constexpr int NWAVES = 8, NTHR = NWAVES * 64;

constexpr size_t MiB = 1u << 20;
constexpr size_t WS_CTL = 0, CTL_ZERO_BYTES = 1 * MiB;
constexpr size_t WS_WIN = 1 * MiB, WS_WUQ = 6 * MiB, WS_WUKV = 7 * MiB, WS_WO = 8 * MiB, WS_WPG = 10 * MiB, WS_WPP = 12 * MiB;
constexpr size_t WS_ROUTE = 13 * MiB, WS_CS = 14 * MiB;
constexpr size_t WS_WGU = 16 * MiB, WS_WDN = 144 * MiB, WS_XN = 208 * MiB, WS_Y1 = 240 * MiB, WS_Q = 312 * MiB, WS_KN = 336 * MiB, WS_VM = 352 * MiB;
constexpr size_t WS_O = 368 * MiB, WS_H1 = 400 * MiB, WS_PBF = 464 * MiB, WS_PROJ = 472 * MiB, WS_XG = 504 * MiB, WS_ACT = 648 * MiB, WS_PARTA = 792 * MiB, WS_PARTO = 793 * MiB, WS_END = 794 * MiB;
constexpr int CW_TMO = 0, CW_CODE = 1, CW_BAR = 4096, CW_CNT = 8192, CW_SSQ = 16384;
constexpr int SSQ_CQ = 0, SSQ_CKV = 1, SSQ_OM = 2, SSQ_OS = 3, SSQ_FIN = 4;
static_assert((CW_SSQ + 5 * T) * 4 <= (int)CTL_ZERO_BYTES, "ctl");

constexpr int RING_OFF = 0, RING_BYTES = 131072;
constexpr int LDSCTL_OFF = RING_BYTES, MISC_OFF = LDSCTL_OFF + 320;
constexpr int L_TSTART = LDSCTL_OFF + 1024;
constexpr int L_LCNT = LDSCTL_OFF + 1280;
constexpr int L_RSCR = LDSCTL_OFF + 2048;
constexpr int L_ROWS = LDSCTL_OFF + 4096;
constexpr int LDS_BYTES = 147456;

#define GAS __attribute__((address_space(1)))
#define LAS __attribute__((address_space(3)))
typedef unsigned short bf16;
typedef unsigned v4u __attribute__((ext_vector_type(4)));
typedef unsigned v2u __attribute__((ext_vector_type(2)));
typedef float f32x4 __attribute__((ext_vector_type(4)));
typedef GAS unsigned gu32;
#define RLX_AGENT __ATOMIC_RELAXED, __HIP_MEMORY_SCOPE_AGENT

__device__ __forceinline__ unsigned f2bf(float f) { unsigned u = __builtin_bit_cast(unsigned, f); return (u + 0x7fffu + ((u >> 16) & 1u)) >> 16; }
__device__ __forceinline__ unsigned pk2(float lo, float hi) { return f2bf(lo) | (f2bf(hi) << 16); }
__device__ __forceinline__ float bflo(unsigned w) { return __uint_as_float(w << 16); }
__device__ __forceinline__ float bfhi(unsigned w) { return __uint_as_float(w & 0xffff0000u); }
__device__ __forceinline__ float bf2f(bf16 v) { return __uint_as_float((unsigned)v << 16); }
__device__ __forceinline__ float wave_sum(float v) {
#pragma unroll
    for (int o = 1; o < 64; o <<= 1) v += __shfl_xor(v, o);
    return v;
}

__device__ __forceinline__ int lane_id() { int l; asm volatile("v_mbcnt_lo_u32_b32 %0, -1, 0\n\tv_mbcnt_hi_u32_b32 %0, -1, %0" : "=v"(l)); return l; }
#define XB_TMO      128
#define XB_XCNT(j)  (256  + 64 * (j))
#define XB_XSUB(j)  (1280 + 64 * (j))
#define XB_XGEN(j)  (2304 + 64 * (j))
#define XB_TOP      3328
#define XB_TOPGEN   3392
#define XCD_BAR_WORDS 3456
#define XB_SPIN_CAP (1u << 18)
__device__ __forceinline__ unsigned xb_ld(unsigned* p)              { return __hip_atomic_load(p, __ATOMIC_RELAXED, __HIP_MEMORY_SCOPE_AGENT); }
__device__ __forceinline__ unsigned xb_add(unsigned* p, unsigned v) { return __hip_atomic_fetch_add(p, v, __ATOMIC_RELAXED, __HIP_MEMORY_SCOPE_AGENT); }
__device__ __forceinline__ unsigned xb_xcc_id() { return (unsigned)__builtin_amdgcn_s_getreg((3 << 11) | 20) & 0xFu; }
#define XB_SPIN(cond, bar) do { unsigned _sp = 0; while (cond) { __builtin_amdgcn_s_sleep(1); \
    if ((++_sp & 255u) == 0u) { if (xb_ld(&(bar)[XB_TMO])) break; if (_sp > XB_SPIN_CAP) { atomicAdd(&(bar)[XB_TMO], 1u); break; } } } } while (0)
struct XcdBarrier { unsigned* bar; unsigned x; volatile LAS unsigned* st; };
__device__ __forceinline__ XcdBarrier xcd_barrier_post(unsigned* bar, volatile LAS unsigned* st) {
    XcdBarrier b; b.bar = bar; b.x = xb_xcc_id(); b.st = st;
    if (threadIdx.x == 0) (void)xb_add(&bar[XB_XCNT(b.x)], 1u);
    return b;
}
__device__ __forceinline__ void xcd_barrier_complete(unsigned* bar, unsigned x, unsigned& nloc, unsigned& nx) {
    const unsigned G = gridDim.x * gridDim.y * gridDim.z;
    unsigned sum, cnt, mine, sp = 0u;
    for (;;) {
        sum = 0u; cnt = 0u; mine = 0u;
#pragma unroll
        for (unsigned j = 0; j < 16; ++j) { const unsigned c = xb_ld(&bar[XB_XCNT(j)]); sum += c; cnt += (c > 0u) ? 1u : 0u; mine = (j == x) ? c : mine; }
        if (sum == G) break;
        __builtin_amdgcn_s_sleep(1);
        if ((++sp & 255u) == 0u) { if (xb_ld(&bar[XB_TMO])) break; if (sp > XB_SPIN_CAP) { atomicAdd(&bar[XB_TMO], 1u); break; } }
    }
    nloc = mine > 0u ? mine : 1u; nx = cnt > 0u ? cnt : 1u;
}
__device__ __forceinline__ void xcd_barrier(const XcdBarrier& b, int wave) {
    asm volatile("s_waitcnt vmcnt(0)" ::: "memory");
    __syncthreads();
    if (wave == 0 && lane_id() == 0) {
        unsigned* bar = b.bar;
        __builtin_amdgcn_s_waitcnt(0);
        unsigned nloc = b.st[0], nx = b.st[1];
        if (nloc == 0u) { xcd_barrier_complete(bar, b.x, nloc, nx); b.st[0] = nloc; b.st[1] = nx; }
        const unsigned old = xb_add(&bar[XB_XSUB(b.x)], 1u);
        const unsigned gen = old / nloc;
        if (old + 1u == (gen + 1u) * nloc) {
            __builtin_amdgcn_fence(__ATOMIC_RELEASE, "agent");
            asm volatile("s_waitcnt vmcnt(0)" ::: "memory");
            const unsigned og = xb_add(&bar[XB_TOP], 1u);
            const unsigned tg = og / nx;
            if (og + 1u == (tg + 1u) * nx) xb_add(&bar[XB_TOPGEN], 1u);
            else XB_SPIN(xb_ld(&bar[XB_TOPGEN]) == tg, bar);
            __builtin_amdgcn_fence(__ATOMIC_ACQUIRE, "agent");
            xb_add(&bar[XB_XGEN(b.x)], 1u);
            asm volatile("s_waitcnt vmcnt(0)" ::: "memory");
        } else {
            XB_SPIN(xb_ld(&bar[XB_XGEN(b.x)]) == gen, bar);
            __builtin_amdgcn_fence(__ATOMIC_ACQUIRE, "agent");
            asm volatile("s_waitcnt vmcnt(0)" ::: "memory");
        }
    }
    __syncthreads();
}

struct Frame {
    LAS unsigned char* lds;
    volatile LAS unsigned* MISC;
    gu32* ctl;
    float *PA, *PO;
    int tid, lane, wave, vcu, G; unsigned char* ws;
    const float *x, *p; const int* pos;
    const float *w_in, *g_attn, *g_cq, *w_uq, *g_ckv, *w_ukv, *g_out_mla, *g_out_sb, *w_o, *g_moe, *w_router, *b_router, *w_gu, *b_gu, *w_dn, *b_dn, *g_ple, *w_ple_gate, *w_ple_proj, *g_final;
    float* out;
    bf16 *XN, *Y1, *Q, *KN, *VM, *O, *PBF, *PROJ, *XG, *ACT, *Yb;
    float *H1, *COS, *SIN;
    int *topk_e, *lpos, *slot; float* gate;
};

__device__ __forceinline__ void p0_prologue(Frame& F) {
    const int gw = F.vcu * NWAVES + F.wave, NGW = F.G * NWAVES;
    for (int m = gw; m < T; m += NGW) {
        const GAS f32x4* xr = (const GAS f32x4*)(F.x + (size_t)m * D) + F.lane;
        f32x4 v[4]; float s = 0.f;
#pragma unroll
        for (int j = 0; j < 4; ++j) { v[j] = xr[64 * j]; s += (v[j].x * v[j].x + v[j].y * v[j].y) + (v[j].z * v[j].z + v[j].w * v[j].w); }
        const float r = 1.0f / sqrtf(wave_sum(s) * (1.f / D) + EPS);
        GAS v2u* o8 = (GAS v2u*)(F.XN + (size_t)m * D) + F.lane;
#pragma unroll
        for (int j = 0; j < 4; ++j) { v2u w; w.x = pk2(v[j].x * r, v[j].y * r); w.y = pk2(v[j].z * r, v[j].w * r); o8[64 * j] = w; }
    }
    const int gt = blockIdx.x * NTHR + F.tid, NT = F.G * NTHR;
    for (int i = gt; i < T * PLE / 4; i += NT) { const f32x4 v = ((const GAS f32x4*)F.p)[i]; v2u w; w.x = pk2(v.x, v.y); w.y = pk2(v.z, v.w); ((GAS v2u*)F.PBF)[i] = w; }
    for (int i = gt; i < T * 16; i += NT) {
        const int m = i >> 4, f = i & 15;
        const float invf = exp2f(-(float)f * (13.287712379549449f / 16.0f));
        const float ang = (float)F.pos[m] * invf;
        double t = (double)ang * 0.15915494309189535; t -= __builtin_rint(t);
        const float fr = (float)t;
        F.COS[i] = __builtin_amdgcn_cosf(fr); F.SIN[i] = __builtin_amdgcn_sinf(fr);
    }
}

__device__ __forceinline__ float sum8(const float* p) { const f32x4 a = *(const GAS f32x4*)p, b = *(const GAS f32x4*)(p + 4); return ((a.x + a.y) + (a.z + a.w)) + ((b.x + b.y) + (b.z + b.w)); }
__device__ __forceinline__ void naive_rowssq(Frame& F) {
    const int gw = F.vcu * NWAVES + F.wave, NGW = F.G * NWAVES;
    for (int m = gw; m < T; m += NGW) {
        float sq = 0.f, skv = 0.f;
        for (int c = F.lane; c < C_KR; c += 64) { const float v = bf2f(F.Y1[(size_t)m * NINP + c]); if (c < C_CKV) sq += v * v; else skv += v * v; }
        sq = wave_sum(sq); skv = wave_sum(skv);
        if (F.lane < 16) F.PA[(size_t)m * 16 + F.lane] = (F.lane == 0) ? sq : (F.lane == 8) ? skv : 0.f;
    }
}
template <class Epi>
__device__ __forceinline__ void naive_gemm(Frame& F, const bf16* A, int lda, int M, const Epi& E) {
    const long total = (long)(M / 8) * E.nv;
    const long gt = (long)blockIdx.x * NTHR + F.tid, NT = (long)F.G * NTHR;
    for (long it = gt; it < total; it += NT) {
        const int j = (int)(it % E.nv), m0 = (int)(it / E.nv) * 8;
        const float* W; int ldw; const float *gk0, *gk1; int c0, c1, ka0, kb0, ka1, kb1;
        if (!E.setup(F, m0, j, W, ldw, gk0, gk1, c0, c1, ka0, kb0, ka1, kb1)) continue;
        float a0[8], a1[8];
#pragma unroll
        for (int r = 0; r < 8; ++r) { a0[r] = 0.f; a1[r] = 0.f; }
        const bf16* Ar = A + (size_t)m0 * lda;
        for (int k = ka0; k < kb0; k += 8) {
            v4u av[8];
#pragma unroll
            for (int r = 0; r < 8; ++r) av[r] = *(const GAS v4u*)(Ar + (size_t)r * lda + k);
#pragma unroll
            for (int kk = 0; kk < 8; ++kk) {
                const float w = W[(size_t)(k + kk) * ldw + c0] * (gk0 ? gk0[k + kk] : 1.f);
#pragma unroll
                for (int r = 0; r < 8; ++r) { const unsigned u = av[r][kk >> 1]; a0[r] += ((kk & 1) ? bfhi(u) : bflo(u)) * w; }
            }
        }
        for (int k = ka1; k < kb1; k += 8) {
            v4u av[8];
#pragma unroll
            for (int r = 0; r < 8; ++r) av[r] = *(const GAS v4u*)(Ar + (size_t)r * lda + k);
#pragma unroll
            for (int kk = 0; kk < 8; ++kk) {
                const float w = W[(size_t)(k + kk) * ldw + c1] * (gk1 ? gk1[k + kk] : 1.f);
#pragma unroll
                for (int r = 0; r < 8; ++r) { const unsigned u = av[r][kk >> 1]; a1[r] += ((kk & 1) ? bfhi(u) : bflo(u)) * w; }
            }
        }
        E.store(F, m0, j, a0, a1);
    }
}

__device__ __forceinline__ int expert_of_tile(Frame& F, int tile) {
    const volatile LAS int* ts = (const volatile LAS int*)(F.lds + L_TSTART);
    int e = -1;
    for (int i = 0; i < NE; ++i) if (tile >= ts[i] && tile < ts[i + 1]) e = i;
    return e;
}

struct NE_InProj {
    int nv;
    __device__ __forceinline__ bool setup(Frame& Fr, int m0, int j, const float*& W, int& ldw, const float*& gk0, const float*& gk1, int& c0, int& c1, int& ka0, int& kb0, int& ka1, int& kb1) const {
        if (j >= C_KR + 16 && j < C_QS) return false;
        W = Fr.w_in; ldw = NIN; gk0 = Fr.g_attn; gk1 = Fr.g_attn; c0 = j; c1 = j; ka0 = 0; kb0 = D; ka1 = 0; kb1 = 0;
        if (j >= C_KR && j < C_KR + 16) { c1 = j + 16; kb1 = D; }
        return true;
    }
    __device__ __forceinline__ void store(Frame& Fr, int m0, int j, const float* a0, const float* a1) const {
#pragma unroll
        for (int r = 0; r < 8; ++r) {
            const int m = m0 + r; bf16* y = Fr.Y1 + (size_t)m * NINP;
            if (j < C_KR) y[j] = (bf16)f2bf(a0[r]);
            else if (j < C_KR + 16) { const int i = j - C_KR; const float c = Fr.COS[m * 16 + i], s = Fr.SIN[m * 16 + i];
                y[C_KR + 2 * i] = (bf16)f2bf(a0[r] * c - a1[r] * s); y[C_KR + 2 * i + 1] = (bf16)f2bf(a1[r] * c + a0[r] * s); }
            else if (j < C_KS) y[j] = (bf16)f2bf(a0[r] * QS_SCALE);
            else y[j] = (bf16)f2bf(a0[r]);
        }
    }
};
struct NE_Q {
    int nv;
    __device__ __forceinline__ bool setup(Frame& Fr, int m0, int j, const float*& W, int& ldw, const float*& gk0, const float*& gk1, int& c0, int& c1, int& ka0, int& kb0, int& ka1, int& kb1) const {
        const int w = j % QKD; if (w >= NOPE + 16) return false;
        W = Fr.w_uq; ldw = HM * QKD; gk0 = Fr.g_cq; gk1 = Fr.g_cq; c0 = j; c1 = j; ka0 = 0; kb0 = QLR; ka1 = 0; kb1 = 0;
        if (w >= NOPE) { c1 = j + 16; kb1 = QLR; }
        return true;
    }
    __device__ __forceinline__ void store(Frame& Fr, int m0, int j, const float* a0, const float* a1) const {
        const int h = j / QKD, w = j % QKD;
#pragma unroll
        for (int r = 0; r < 8; ++r) {
            const int m = m0 + r; bf16* q = Fr.Q + (size_t)m * (HM * QKD) + h * QKD;
            const float rinv = 1.0f / sqrtf(sum8(Fr.PA + (size_t)m * 16) * (1.f / QLR) + EPS) * Q_SCALE;
            if (w < NOPE) q[w] = (bf16)f2bf(a0[r] * rinv);
            else { const int i = w - NOPE; const float c = Fr.COS[m * 16 + i], s = Fr.SIN[m * 16 + i]; const float x1 = a0[r] * rinv, x2 = a1[r] * rinv;
                q[NOPE + 2 * i] = (bf16)f2bf(x1 * c - x2 * s); q[NOPE + 2 * i + 1] = (bf16)f2bf(x2 * c + x1 * s); }
        }
    }
};
struct NE_KV {
    int nv;
    __device__ __forceinline__ bool setup(Frame& Fr, int m0, int j, const float*& W, int& ldw, const float*& gk0, const float*& gk1, int& c0, int& c1, int& ka0, int& kb0, int& ka1, int& kb1) const {
        W = Fr.w_ukv; ldw = HM * (NOPE + VDIM); gk0 = Fr.g_ckv; gk1 = nullptr; c0 = j; c1 = j; ka0 = 0; kb0 = KVLR; ka1 = 0; kb1 = 0; return true;
    }
    __device__ __forceinline__ void store(Frame& Fr, int m0, int j, const float* a0, const float* a1) const {
        const int h = j / 128, w = j % 128;
#pragma unroll
        for (int r = 0; r < 8; ++r) {
            const int m = m0 + r;
            const float rinv = 1.0f / sqrtf(sum8(Fr.PA + (size_t)m * 16 + 8) * (1.f / KVLR) + EPS);
            if (w < NOPE) Fr.KN[(size_t)m * 512 + h * 64 + w] = (bf16)f2bf(a0[r] * rinv);
            else Fr.VM[(size_t)m * 512 + h * 64 + (w - NOPE)] = (bf16)f2bf(a0[r] * rinv);
        }
    }
};
struct NE_Wo {
    int nv;
    __device__ __forceinline__ bool setup(Frame& Fr, int m0, int j, const float*& W, int& ldw, const float*& gk0, const float*& gk1, int& c0, int& c1, int& ka0, int& kb0, int& ka1, int& kb1) const {
        W = Fr.w_o; ldw = D; gk0 = Fr.g_out_mla; gk1 = Fr.g_out_sb - 512; c0 = j; c1 = j; ka0 = 0; kb0 = 512; ka1 = 512; kb1 = 1024; return true;
    }
    __device__ __forceinline__ void store(Frame& Fr, int m0, int j, const float* a0, const float* a1) const {
#pragma unroll
        for (int r = 0; r < 8; ++r) {
            const int m = m0 + r;
            const float rm = 1.0f / sqrtf(sum8(Fr.PO + (size_t)m * 16) * (1.f / 512) + EPS), rs = 1.0f / sqrtf(sum8(Fr.PO + (size_t)m * 16 + 8) * (1.f / 512) + EPS);
            Fr.H1[(size_t)m * D + j] = Fr.x[(size_t)m * D + j] + a0[r] * rm + a1[r] * rs;
        }
    }
};
struct NE_Gu {
    int nv;
    __device__ __forceinline__ bool setup(Frame& Fr, int m0, int j, const float*& W, int& ldw, const float*& gk0, const float*& gk1, int& c0, int& c1, int& ka0, int& kb0, int& ka1, int& kb1) const {
        const int e = expert_of_tile(Fr, m0 >> 8); if (e < 0) return false;
        W = Fr.w_gu + (size_t)e * D * 2 * DFF; ldw = 2 * DFF; gk0 = Fr.g_moe; gk1 = Fr.g_moe; c0 = j; c1 = DFF + j; ka0 = 0; kb0 = D; ka1 = 0; kb1 = D; return true;
    }
    __device__ __forceinline__ void store(Frame& Fr, int m0, int j, const float* a0, const float* a1) const {
        const int e = expert_of_tile(Fr, m0 >> 8);
        const float bg = Fr.b_gu[e * 2 * DFF + j], bl = Fr.b_gu[e * 2 * DFF + DFF + j];
#pragma unroll
        for (int r = 0; r < 8; ++r) {
            float g = fminf(a0[r] + bg, 7.0f), l = fminf(fmaxf(a1[r] + bl, -7.0f), 7.0f);
            const float act = g * (1.0f / (1.0f + __expf(-1.702f * g))) * (l + 1.0f);
            Fr.ACT[(size_t)(m0 + r) * DFF + j] = (bf16)f2bf(act);
        }
    }
};
struct NE_Dn {
    int nv;
    __device__ __forceinline__ bool setup(Frame& Fr, int m0, int j, const float*& W, int& ldw, const float*& gk0, const float*& gk1, int& c0, int& c1, int& ka0, int& kb0, int& ka1, int& kb1) const {
        const int e = expert_of_tile(Fr, m0 >> 8); if (e < 0) return false;
        W = Fr.w_dn + (size_t)e * DFF * D; ldw = D; gk0 = nullptr; gk1 = nullptr; c0 = j; c1 = j; ka0 = 0; kb0 = DFF; ka1 = 0; kb1 = 0; return true;
    }
    __device__ __forceinline__ void store(Frame& Fr, int m0, int j, const float* a0, const float* a1) const {
        const int e = expert_of_tile(Fr, m0 >> 8);
        const float b = Fr.b_dn[e * D + j];
#pragma unroll
        for (int r = 0; r < 8; ++r) Fr.Yb[(size_t)(m0 + r) * D + j] = (bf16)f2bf(a0[r] + b);
    }
};
struct NE_Proj {
    int nv;
    __device__ __forceinline__ bool setup(Frame& Fr, int m0, int j, const float*& W, int& ldw, const float*& gk0, const float*& gk1, int& c0, int& c1, int& ka0, int& kb0, int& ka1, int& kb1) const {
        W = Fr.w_ple_proj; ldw = D; gk0 = nullptr; gk1 = nullptr; c0 = j; c1 = j; ka0 = 0; kb0 = PLE; ka1 = 0; kb1 = 0; return true;
    }
    __device__ __forceinline__ void store(Frame& Fr, int m0, int j, const float* a0, const float* a1) const {
#pragma unroll
        for (int r = 0; r < 8; ++r) Fr.PROJ[(size_t)(m0 + r) * D + j] = (bf16)f2bf(a0[r]);
    }
};
struct NE_Gate {
    int nv;
    __device__ __forceinline__ bool setup(Frame& Fr, int m0, int j, const float*& W, int& ldw, const float*& gk0, const float*& gk1, int& c0, int& c1, int& ka0, int& kb0, int& ka1, int& kb1) const {
        W = Fr.w_ple_gate; ldw = D; gk0 = Fr.g_ple; gk1 = nullptr; c0 = j; c1 = j; ka0 = 0; kb0 = D; ka1 = 0; kb1 = 0; return true;
    }
    __device__ __forceinline__ void store(Frame& Fr, int m0, int j, const float* a0, const float* a1) const {
#pragma unroll
        for (int r = 0; r < 8; ++r) {
            const int m = m0 + r;
            const float h3 = Fr.H1[(size_t)m * D + j] + (1.0f / (1.0f + __expf(-a0[r]))) * bf2f(Fr.PROJ[(size_t)m * D + j]);
            Fr.out[(size_t)m * D + j] = h3;
        }
    }
};

__device__ __forceinline__ void naive_attention(Frame& F) {
    const long gt = (long)blockIdx.x * NTHR + F.tid, NT = (long)F.G * NTHR;
    const long total = 2L * T * 8;
    for (long it = gt; it < total; it += NT) {
        const int tl = (int)(it & 63); long r = it >> 6;
        const int h = (int)(r & 7); r >>= 3; const int grp = (int)(r & 1); r >>= 1; const int b = (int)(r & 3); r >>= 2; const int tc = (int)r;
        const int t = tc * 64 + tl; const int m = b * SEQ + t;
        float o[64];
#pragma unroll
        for (int d = 0; d < 64; ++d) o[d] = 0.f;
        if (grp == 0) {
            unsigned q[48];
            const GAS v4u* qp = (const GAS v4u*)(F.Q + (size_t)m * (HM * QKD) + h * QKD);
#pragma unroll
            for (int c = 0; c < 12; ++c) { const v4u v = qp[c]; q[4 * c] = v.x; q[4 * c + 1] = v.y; q[4 * c + 2] = v.z; q[4 * c + 3] = v.w; }
            float mx = -1e30f, l = 0.f;
            for (int s = 0; s <= t; ++s) {
                const int ms = b * SEQ + s;
                const GAS v4u* kp = (const GAS v4u*)(F.KN + (size_t)ms * 512 + h * 64);
                const GAS v4u* kr = (const GAS v4u*)(F.Y1 + (size_t)ms * NINP + C_KR);
                float sc = 0.f;
#pragma unroll
                for (int c = 0; c < 12; ++c) { const v4u kv = (c < 8) ? kp[c] : kr[c - 8];
#pragma unroll
                    for (int i = 0; i < 4; ++i) sc += bflo(q[4 * c + i]) * bflo(kv[i]) + bfhi(q[4 * c + i]) * bfhi(kv[i]); }
                const float mn = fmaxf(mx, sc), al = exp2f(mx - mn), pp = exp2f(sc - mn);
                l = l * al + pp; mx = mn;
                const GAS v4u* vp = (const GAS v4u*)(F.VM + (size_t)ms * 512 + h * 64);
#pragma unroll
                for (int c = 0; c < 8; ++c) { const v4u vv = vp[c];
#pragma unroll
                    for (int i = 0; i < 4; ++i) { o[8 * c + 2 * i] = o[8 * c + 2 * i] * al + pp * bflo(vv[i]); o[8 * c + 2 * i + 1] = o[8 * c + 2 * i + 1] * al + pp * bfhi(vv[i]); } }
            }
            const float rl = 1.0f / l;
#pragma unroll
            for (int d = 0; d < 64; ++d) o[d] *= rl;
        } else {
            unsigned q[32];
            const GAS v4u* qp = (const GAS v4u*)(F.Y1 + (size_t)m * NINP + C_QS + h * 64);
#pragma unroll
            for (int c = 0; c < 8; ++c) { const v4u v = qp[c]; q[4 * c] = v.x; q[4 * c + 1] = v.y; q[4 * c + 2] = v.z; q[4 * c + 3] = v.w; }
            float run = 0.f;
            for (int s = t - 1; s >= 0; --s) {
                if (run < SB_DONE) break;
                const int ms = b * SEQ + s;
                const GAS v4u* kp = (const GAS v4u*)(F.Y1 + (size_t)ms * NINP + C_KS + h * 64);
                float z = 0.f;
#pragma unroll
                for (int c = 0; c < 8; ++c) { const v4u kv = kp[c];
#pragma unroll
                    for (int i = 0; i < 4; ++i) z += bflo(q[4 * c + i]) * bflo(kv[i]) + bfhi(q[4 * c + i]) * bfhi(kv[i]); }
                const float sp = fmaxf(z, 0.f) + log2f(1.0f + exp2f(-fabsf(z)));
                const float a = exp2f(z - sp + run);
                run -= sp;
                const GAS v4u* vp = (const GAS v4u*)(F.Y1 + (size_t)ms * NINP + C_VS + h * 64);
#pragma unroll
                for (int c = 0; c < 8; ++c) { const v4u vv = vp[c];
#pragma unroll
                    for (int i = 0; i < 4; ++i) { o[8 * c + 2 * i] += a * bflo(vv[i]); o[8 * c + 2 * i + 1] += a * bfhi(vv[i]); } }
            }
        }
        float ss = 0.f;
        GAS v4u* op = (GAS v4u*)(F.O + (size_t)m * D + grp * 512 + h * 64);
#pragma unroll
        for (int c = 0; c < 8; ++c) { v4u w;
#pragma unroll
            for (int i = 0; i < 4; ++i) { w[i] = pk2(o[8 * c + 2 * i], o[8 * c + 2 * i + 1]); ss += o[8 * c + 2 * i] * o[8 * c + 2 * i] + o[8 * c + 2 * i + 1] * o[8 * c + 2 * i + 1]; }
            op[c] = w; }
        F.PO[(size_t)m * 16 + grp * 8 + h] = ss;
    }
}

__device__ __forceinline__ void p5a_route(Frame& F) {
    LAS float* WR = (LAS float*)(F.lds + RING_OFF);
    for (int i = F.tid; i < D * NE / 4; i += NTHR) {
        const f32x4 v = ((const GAS f32x4*)F.w_router)[i]; const int k = (4 * i) / NE, e0 = (4 * i) % NE; const float g = F.g_moe[k];
        WR[(e0 + 0) * D + k] = v.x * g; WR[(e0 + 1) * D + k] = v.y * g; WR[(e0 + 2) * D + k] = v.z * g; WR[(e0 + 3) * D + k] = v.w * g;
    }
    volatile LAS unsigned* lcnt = (volatile LAS unsigned*)(F.lds + L_LCNT);
    LAS unsigned* rscr = (LAS unsigned*)(F.lds + L_RSCR) + F.wave * 64;
    if (F.tid < 64) lcnt[F.tid] = 0u;
    __syncthreads();
    const int gw = F.vcu * NWAVES + F.wave, NGW = F.G * NWAVES;
    const int lane = F.lane;
    const int myexp = ((lane & 1) << 4) | ((lane & 2) << 2) | (lane & 4) | ((lane & 8) >> 2) | ((lane & 16) >> 4);
    const float mybias = F.b_router[myexp];
    int ri = 0;
    for (int m = gw; m < T; m += NGW, ++ri) {
        const GAS f32x4* xr = (const GAS f32x4*)(F.H1 + (size_t)m * D) + lane;
        f32x4 v[4]; float s = 0.f;
#pragma unroll
        for (int j = 0; j < 4; ++j) { v[j] = xr[64 * j]; s += (v[j].x * v[j].x + v[j].y * v[j].y) + (v[j].z * v[j].z + v[j].w * v[j].w); }
        const float r = 1.0f / sqrtf(wave_sum(s) * (1.f / D) + EPS);
        GAS v2u* o8 = (GAS v2u*)(F.XN + (size_t)m * D) + lane;
#pragma unroll
        for (int j = 0; j < 4; ++j) { v[j] = v[j] * r; v2u w; w.x = pk2(v[j].x, v[j].y); w.y = pk2(v[j].z, v[j].w); o8[64 * j] = w; }
        float a[32];
#pragma unroll
        for (int e = 0; e < 32; ++e) {
            float acc = 0.f;
#pragma unroll
            for (int j = 0; j < 4; ++j) { const f32x4 w = *(const LAS f32x4*)(WR + e * D + 256 * j + 4 * lane); acc += (v[j].x * w.x + v[j].y * w.y) + (v[j].z * w.z + v[j].w * w.w); }
            a[e] = acc;
            if ((e & 1) == 1) __builtin_amdgcn_sched_barrier(0);
        }
#pragma unroll
        for (int st = 0; st < 5; ++st) {
            const int hh = 16 >> st; const bool up = (lane >> st) & 1;
#pragma unroll
            for (int i = 0; i < hh; ++i) { const float send = up ? a[i] : a[hh + i]; const float recv = __shfl_xor(send, 1 << st); a[i] = (up ? a[hh + i] : a[i]) + recv; }
        }
        float val = a[0] + __shfl_xor(a[0], 32) + mybias;
        int tv_i[4]; float tv_v[4];
#pragma unroll
        for (int k = 0; k < 4; ++k) {
            float bv = val; int bi = myexp;
#pragma unroll
            for (int off = 1; off < 32; off <<= 1) { const float ov = __shfl_xor(bv, off); const int oi = __shfl_xor(bi, off); if (ov > bv || (ov == bv && oi < bi)) { bv = ov; bi = oi; } }
            tv_v[k] = bv; tv_i[k] = bi; if (myexp == bi) val = -INFINITY;
        }
        float g[4], gs = 0.f;
#pragma unroll
        for (int k = 0; k < 4; ++k) { g[k] = __expf(tv_v[k] - tv_v[0]); gs += g[k]; }
        const float rg = 1.0f / gs;
        if (lane == 0) {
#pragma unroll
            for (int k = 0; k < 4; ++k) {
                const unsigned pos = __hip_atomic_fetch_add((LAS unsigned*)(F.lds + L_LCNT) + tv_i[k], 1u, __ATOMIC_RELAXED, __HIP_MEMORY_SCOPE_WORKGROUP);
                F.topk_e[m * 4 + k] = tv_i[k]; F.gate[m * 4 + k] = g[k] * rg;
                if (ri < 8) { rscr[ri * 8 + k] = (unsigned)tv_i[k]; rscr[ri * 8 + 4 + k] = pos; }
            }
        }
    }
    __syncthreads();
    if (F.tid < 32) lcnt[32 + F.tid] = __hip_atomic_fetch_add((unsigned*)(F.ctl + CW_CNT) + F.tid, lcnt[F.tid], RLX_AGENT);
    __syncthreads();
    ri = 0;
    for (int m = gw; m < T; m += NGW, ++ri) if (lane < 4 && ri < 8) F.lpos[m * 4 + lane] = (int)(rscr[ri * 8 + 4 + lane] + lcnt[32 + rscr[ri * 8 + lane]]);
}
__device__ __forceinline__ void build_tstart(Frame& F) {
    volatile LAS int* ts = (volatile LAS int*)(F.lds + L_TSTART);
    if (F.tid == 0) { int acc = 0; for (int e = 0; e < NE; ++e) { ts[e] = acc; const unsigned c = __hip_atomic_load((unsigned*)(F.ctl + CW_CNT) + e, RLX_AGENT); acc += (int)((c + 255u) >> 8); } ts[NE] = acc; ts[40] = acc; }
    __syncthreads();
}
__device__ __forceinline__ void p5b_gather(Frame& F) {
    build_tstart(F);
    const volatile LAS int* ts = (const volatile LAS int*)(F.lds + L_TSTART);
    const int gw = F.vcu * NWAVES + F.wave, NGW = F.G * NWAVES;
    for (int m = gw; m < T; m += NGW) {
        const GAS v4u* src = (const GAS v4u*)(F.XN + (size_t)m * D) + F.lane;
        const v4u a = src[0], b = src[64];
#pragma unroll
        for (int k = 0; k < 4; ++k) {
            const int e = F.topk_e[m * 4 + k]; const int sl = ts[e] * 256 + F.lpos[m * 4 + k];
            if (F.lane == 0) F.slot[m * 4 + k] = sl;
            GAS v4u* dst = (GAS v4u*)(F.XG + (size_t)sl * D) + F.lane; dst[0] = a; dst[64] = b;
        }
    }
}
__device__ __forceinline__ void p8_combine(Frame& F) {
    const int gw = F.vcu * NWAVES + F.wave, NGW = F.G * NWAVES; const int lane = F.lane;
    for (int m = gw; m < T; m += NGW) {
        int sl[4]; float g[4];
#pragma unroll
        for (int k = 0; k < 4; ++k) { sl[k] = F.slot[m * 4 + k]; g[k] = F.gate[m * 4 + k]; }
        f32x4 h[2][2]; float s = 0.f;
#pragma unroll
        for (int j = 0; j < 2; ++j) {
            GAS f32x4* hp = (GAS f32x4*)(F.H1 + (size_t)m * D + 512 * j + 8 * lane);
            h[j][0] = hp[0]; h[j][1] = hp[1];
#pragma unroll
            for (int k = 0; k < 4; ++k) {
                const v4u y = *(const GAS v4u*)(F.Yb + (size_t)sl[k] * D + 512 * j + 8 * lane);
                h[j][0].x += g[k] * bflo(y.x); h[j][0].y += g[k] * bfhi(y.x); h[j][0].z += g[k] * bflo(y.y); h[j][0].w += g[k] * bfhi(y.y);
                h[j][1].x += g[k] * bflo(y.z); h[j][1].y += g[k] * bfhi(y.z); h[j][1].z += g[k] * bflo(y.w); h[j][1].w += g[k] * bfhi(y.w);
            }
            hp[0] = h[j][0]; hp[1] = h[j][1];
#pragma unroll
            for (int i = 0; i < 2; ++i) s += (h[j][i].x * h[j][i].x + h[j][i].y * h[j][i].y) + (h[j][i].z * h[j][i].z + h[j][i].w * h[j][i].w);
        }
        const float r = 1.0f / sqrtf(wave_sum(s) * (1.f / D) + EPS);
#pragma unroll
        for (int j = 0; j < 2; ++j) { v4u w; w.x = pk2(h[j][0].x * r, h[j][0].y * r); w.y = pk2(h[j][0].z * r, h[j][0].w * r); w.z = pk2(h[j][1].x * r, h[j][1].y * r); w.w = pk2(h[j][1].z * r, h[j][1].w * r);
            *(GAS v4u*)(F.XN + (size_t)m * D + 512 * j + 8 * lane) = w; }
    }
}
__device__ __forceinline__ void p10_final(Frame& F) {
    const int gw = F.vcu * NWAVES + F.wave, NGW = F.G * NWAVES; const int lane = F.lane;
    for (int m = gw; m < T; m += NGW) {
        GAS f32x4* op = (GAS f32x4*)(F.out + (size_t)m * D) + lane;
        f32x4 v[4]; float s = 0.f;
#pragma unroll
        for (int j = 0; j < 4; ++j) { v[j] = op[64 * j]; s += (v[j].x * v[j].x + v[j].y * v[j].y) + (v[j].z * v[j].z + v[j].w * v[j].w); }
        const float r = 1.0f / sqrtf(wave_sum(s) * (1.f / D) + EPS);
#pragma unroll
        for (int j = 0; j < 4; ++j) { const f32x4 g = ((const GAS f32x4*)F.g_final)[64 * j + lane]; op[64 * j] = v[j] * r * g; }
    }
}

namespace pg8 {
#define PG8_LAS __attribute__((address_space(3)))
typedef unsigned short bf16_t;
typedef short bf16x8 __attribute__((ext_vector_type(8)));
typedef unsigned u32x4 __attribute__((ext_vector_type(4)));
typedef unsigned u32x2 __attribute__((ext_vector_type(2)));
constexpr int BM = 256, BK = 64, HALF = 128, HTB = HALF * BK * 2, STAGE_BYTES = 8 * HTB, NXCD = 8, WGM = 8;
__host__ __device__ __forceinline__ int lds_byte(int r, int c) { const int st = (r >> 4) * 2 + (c >> 5), rr = r & 15, cc = c & 31, ob = rr * 64 + cc * 2; return st * 1024 + (ob ^ (((ob >> 9) & 1) << 5)); }
__host__ __device__ __forceinline__ void stage_rc(int b, int& R, int& C) { const int st = b / 1024, sb = b % 1024, swz = sb ^ (((sb >> 9) & 1) << 5); R = (st >> 1) * 16 + swz / 64; C = (st & 1) * 32 + (swz % 64) / 2; }
__host__ __device__ __forceinline__ int perm32(int rho) { const int n = rho >> 4, i = rho & 15; return 8 * (i >> 2) + 4 * n + (i & 3); }

struct Unit { int pm, pn, pb, e; };
struct Gemm { const bf16_t* A; int lda; const bf16_t* Bt; int ldb; int K; };

struct StaticOrder {
    int nM, nN, nwg, G, c;
    __device__ void init(int nM_, int nN_, int G_, int c_) { nM = nM_; nN = nN_; nwg = nM * nN; G = G_; c = c_; }
    __device__ bool next(int i, Unit& u) const {
        const long L = (long)i * G + c; if (c < 0 || L >= nwg) return false;
        int wgid = (int)L; { const int q = nwg / NXCD, r = nwg % NXCD, xcd = wgid % NXCD, off = wgid / NXCD; wgid = (xcd < r ? xcd * (q + 1) : r * (q + 1) + (xcd - r) * q) + off; }
        const int nig = WGM * nN, gid = wgid / nig, fm = gid * WGM, gsz = (nM - fm) < WGM ? (nM - fm) : WGM;
        u.pm = fm + ((wgid % nig) % gsz); u.pn = (wgid % nig) / gsz; u.pb = u.pn; u.e = 0; return true;
    }
};
struct GroupedOrder : StaticOrder {
    const volatile PG8_LAS int* ts;
    __device__ bool next(int i, Unit& u) const {
        if (!StaticOrder::next(i, u)) return false;
        int e = 0;
        for (int j = 1; j < 32; ++j) e = (u.pm >= ts[j]) ? j : e;
        u.e = e; u.pb = e * nN + u.pn; return true;
    }
};

__device__ __forceinline__ unsigned cvt_pk_bf16(float lo, float hi) { unsigned r; asm volatile("v_cvt_pk_bf16_f32 %0, %1, %2" : "=v"(r) : "v"(lo), "v"(hi)); return r; }
__device__ __forceinline__ u32x4 pack8(const f32x4& a, const f32x4& b) { u32x4 w; w.x = cvt_pk_bf16(a[0], a[1]); w.y = cvt_pk_bf16(a[2], a[3]); w.z = cvt_pk_bf16(b[0], b[1]); w.w = cvt_pk_bf16(b[2], b[3]); return w; }
__device__ __forceinline__ float psum8(const float* p) { const f32x4 a = *(const f32x4*)p, b = *(const f32x4*)(p + 4); return ((a[0] + a[1]) + (a[2] + a[3])) + ((b[0] + b[1]) + (b[2] + b[3])); }
__device__ __forceinline__ void rope8(f32x4& a, f32x4& b, const f32x4& c, const f32x4& s) {
    const float a0 = a[0] * c[0] - a[1] * s[0], a1 = a[1] * c[0] + a[0] * s[0], a2 = a[2] * c[1] - a[3] * s[1], a3 = a[3] * c[1] + a[2] * s[1];
    const float b0 = b[0] * c[2] - b[1] * s[2], b1 = b[1] * c[2] + b[0] * s[2], b2 = b[2] * c[3] - b[3] * s[3], b3 = b[3] * c[3] + b[2] * s[3];
    a = (f32x4){a0, a1, a2, a3}; b = (f32x4){b0, b1, b2, b3};
}
struct EpiStoreBf16 {
    static constexpr bool PERM = true, AFTER_DRAIN = false, HAS_MID = false;
    bf16_t* O; int ldc;
    __device__ __forceinline__ void operator()(const f32x4 (&acc)[2][2][4][2], const Unit& u, int wr, int wc, int fr, int fq) const {
        const int row0 = u.pm * BM + wr * 64 + fr, col0 = u.pn * BM + wc * 32 + 8 * fq;
#pragma unroll
        for (int ai = 0; ai < 2; ++ai)
#pragma unroll
            for (int m = 0; m < 4; ++m) { bf16_t* rowp = O + (size_t)(row0 + ai * HALF + m * 16) * ldc + col0;
#pragma unroll
                for (int bj = 0; bj < 2; ++bj) *(u32x4*)(rowp + bj * HALF) = pack8(acc[ai][bj][m][0], acc[ai][bj][m][1]); }
    }
};
struct EpiInProj {
    static constexpr bool PERM = true, AFTER_DRAIN = false, HAS_MID = false;
    bf16_t* Y; float* PA; const float* COS; const float* SIN;
    __device__ __forceinline__ void operator()(const f32x4 (&acc)[2][2][4][2], const Unit& u, int wr, int wc, int fr, int fq) const {
        const int row0 = u.pm * BM + wr * 64 + fr, col0 = u.pn * BM + wc * 32 + 8 * fq;
        const bool rope = (u.pn == 2 && wc == 0);
#pragma unroll
        for (int ai = 0; ai < 2; ++ai)
#pragma unroll
            for (int m = 0; m < 4; ++m) {
                const int row = row0 + ai * HALF + m * 16;
                f32x4 v00 = acc[ai][0][m][0], v01 = acc[ai][0][m][1], v10 = acc[ai][1][m][0], v11 = acc[ai][1][m][1];
                if (u.pn <= 2) {
                    float s0 = ((v00[0] * v00[0] + v00[1] * v00[1]) + (v00[2] * v00[2] + v00[3] * v00[3])) + ((v01[0] * v01[0] + v01[1] * v01[1]) + (v01[2] * v01[2] + v01[3] * v01[3]));
                    float s1 = ((v10[0] * v10[0] + v10[1] * v10[1]) + (v10[2] * v10[2] + v10[3] * v10[3])) + ((v11[0] * v11[0] + v11[1] * v11[1]) + (v11[2] * v11[2] + v11[3] * v11[3]));
                    s0 += __shfl_xor(s0, 16); s0 += __shfl_xor(s0, 32); s1 += __shfl_xor(s1, 16); s1 += __shfl_xor(s1, 32);
                    if (fq == 0) {
                        if (u.pn == 0) PA[(size_t)row * 16 + wc] = s0 + s1;
                        else if (u.pn == 1) { PA[(size_t)row * 16 + 4 + wc] = s0; PA[(size_t)row * 16 + 8 + wc] = s1; }
                        else PA[(size_t)row * 16 + 12 + wc] = s0;
                    }
                }
                if (rope) { const f32x4 c = *(const f32x4*)(COS + (size_t)row * 16 + 4 * fq), s = *(const f32x4*)(SIN + (size_t)row * 16 + 4 * fq); rope8(v10, v11, c, s); }
                bf16_t* rowp = Y + (size_t)row * NINP + col0;
                *(u32x4*)(rowp) = pack8(v00, v01); *(u32x4*)(rowp + HALF) = pack8(v10, v11);
            }
    }
};
struct EpiQ {
    static constexpr bool PERM = true, AFTER_DRAIN = false, HAS_MID = false;
    bf16_t* Q; const float* PA; const float* COS; const float* SIN;
    __device__ __forceinline__ void operator()(const f32x4 (&acc)[2][2][4][2], const Unit& u, int wr, int wc, int fr, int fq) const {
        const int row0 = u.pm * BM + wr * 64 + fr, col0 = u.pn * BM + wc * 32 + 8 * fq;
        const bool rope0 = ((8 * u.pn + wc) % 3) == 2, rope1 = ((8 * u.pn + 4 + wc) % 3) == 2;
#pragma unroll
        for (int ai = 0; ai < 2; ++ai)
#pragma unroll
            for (int m = 0; m < 4; ++m) {
                const int row = row0 + ai * HALF + m * 16;
                const float rinv = 1.0f / sqrtf(psum8(PA + (size_t)row * 16) * (1.f / QLR) + EPS);
                f32x4 v00 = acc[ai][0][m][0] * rinv, v01 = acc[ai][0][m][1] * rinv, v10 = acc[ai][1][m][0] * rinv, v11 = acc[ai][1][m][1] * rinv;
                if (rope0 || rope1) { const f32x4 c = *(const f32x4*)(COS + (size_t)row * 16 + 4 * fq), s = *(const f32x4*)(SIN + (size_t)row * 16 + 4 * fq);
                    if (rope0) rope8(v00, v01, c, s); if (rope1) rope8(v10, v11, c, s); }
                bf16_t* rowp = Q + (size_t)row * (HM * QKD) + col0;
                *(u32x4*)(rowp) = pack8(v00, v01); *(u32x4*)(rowp + HALF) = pack8(v10, v11);
                asm volatile("" ::: "memory");
            }
    }
};
struct EpiKV {
    static constexpr bool PERM = true, AFTER_DRAIN = false, HAS_MID = false;
    bf16_t* KNp; bf16_t* VMp; const float* PA;
    __device__ __forceinline__ void operator()(const f32x4 (&acc)[2][2][4][2], const Unit& u, int wr, int wc, int fr, int fq) const {
        const int row0 = u.pm * BM + wr * 64 + fr, col0 = (u.pn & 1) * BM + wc * 32 + 8 * fq;
        bf16_t* base = (u.pn < 2) ? KNp : VMp;
#pragma unroll
        for (int ai = 0; ai < 2; ++ai)
#pragma unroll
            for (int m = 0; m < 4; ++m) {
                const int row = row0 + ai * HALF + m * 16;
                const float rinv = 1.0f / sqrtf(psum8(PA + (size_t)row * 16 + 8) * (1.f / KVLR) + EPS);
                bf16_t* rowp = base + (size_t)row * 512 + col0;
#pragma unroll
                for (int bj = 0; bj < 2; ++bj) *(u32x4*)(rowp + bj * HALF) = pack8(acc[ai][bj][m][0] * rinv, acc[ai][bj][m][1] * rinv);
                asm volatile("" ::: "memory");
            }
    }
};
struct EpiWo {
    static constexpr bool PERM = false, AFTER_DRAIN = false, HAS_MID = true;
    const float* X; float* H; const float* PO; PG8_LAS float* RAT; PG8_LAS float* RS;
    __device__ __forceinline__ void begin(const Unit& u, int t) const {
        if (t < 256) { const int row = u.pm * BM + t;
            const float rm = 1.0f / sqrtf(psum8(PO + (size_t)row * 16) * (1.f / 512) + EPS), rs = 1.0f / sqrtf(psum8(PO + (size_t)row * 16 + 8) * (1.f / 512) + EPS);
            RAT[t] = rm / rs; RS[t] = rs; }
    }
    __device__ __forceinline__ void mid(f32x4 (&acc)[2][2][4][2], int wr, int fr) const {
#pragma unroll
        for (int ai = 0; ai < 2; ++ai)
#pragma unroll
            for (int m = 0; m < 4; ++m) { const float f = RAT[ai * HALF + wr * 64 + m * 16 + fr];
#pragma unroll
                for (int bj = 0; bj < 2; ++bj)
#pragma unroll
                    for (int n = 0; n < 2; ++n) acc[ai][bj][m][n] = acc[ai][bj][m][n] * f; }
    }
    __device__ __forceinline__ void operator()(const f32x4 (&acc)[2][2][4][2], const Unit& u, int wr, int wc, int fr, int fq) const {
        const int row0 = u.pm * BM + wr * 64 + fr, col0 = u.pn * BM + wc * 32 + 4 * fq;
#pragma unroll
        for (int ai = 0; ai < 2; ++ai)
#pragma unroll
            for (int m = 0; m < 4; ++m) { const float rs = RS[ai * HALF + wr * 64 + m * 16 + fr]; const size_t off = (size_t)(row0 + ai * HALF + m * 16) * D + col0;
#pragma unroll
                for (int bj = 0; bj < 2; ++bj)
#pragma unroll
                    for (int n = 0; n < 2; ++n) { const f32x4 xv = *(const f32x4*)(X + off + bj * HALF + n * 16); *(f32x4*)(H + off + bj * HALF + n * 16) = xv + acc[ai][bj][m][n] * rs; } }
    }
};
struct EpiGu {
    static constexpr bool PERM = true, AFTER_DRAIN = false, HAS_MID = false;
    bf16_t* ACTp; const float* bgu;
    __device__ __forceinline__ void operator()(const f32x4 (&acc)[2][2][4][2], const Unit& u, int wr, int wc, int fr, int fq) const {
        const int row0 = u.pm * BM + wr * 64 + fr, cg = u.pn * HALF + wc * 32 + 8 * fq;
        const float* bb = bgu + (size_t)u.e * (2 * DFF) + cg;
        const f32x4 bg0 = *(const f32x4*)(bb), bg1 = *(const f32x4*)(bb + 4), bl0 = *(const f32x4*)(bb + DFF), bl1 = *(const f32x4*)(bb + DFF + 4);
#pragma unroll
        for (int ai = 0; ai < 2; ++ai)
#pragma unroll
            for (int m = 0; m < 4; ++m) {
                f32x4 o[2];
#pragma unroll
                for (int n = 0; n < 2; ++n) { const f32x4 g4 = acc[ai][0][m][n] + (n ? bg1 : bg0), l4 = acc[ai][1][m][n] + (n ? bl1 : bl0);
#pragma unroll
                    for (int i = 0; i < 4; ++i) { const float g = fminf(g4[i], 7.0f), l = fminf(fmaxf(l4[i], -7.0f), 7.0f);
                        o[n][i] = g * __builtin_amdgcn_rcpf(1.0f + __builtin_amdgcn_exp2f(-1.702f * LOG2E * g)) * (l + 1.0f); } }
                *(u32x4*)(ACTp + (size_t)(row0 + ai * HALF + m * 16) * DFF + cg) = pack8(o[0], o[1]);
            }
    }
};
struct EpiDn {
    static constexpr bool PERM = true, AFTER_DRAIN = false, HAS_MID = false;
    bf16_t* Yp; const float* bdn;
    __device__ __forceinline__ void operator()(const f32x4 (&acc)[2][2][4][2], const Unit& u, int wr, int wc, int fr, int fq) const {
        const int row0 = u.pm * BM + wr * 64 + fr, col0 = u.pn * BM + wc * 32 + 8 * fq;
        const float* bb = bdn + (size_t)u.e * D + col0;
        f32x4 bv[2][2];
#pragma unroll
        for (int bj = 0; bj < 2; ++bj)
#pragma unroll
            for (int n = 0; n < 2; ++n) bv[bj][n] = *(const f32x4*)(bb + bj * HALF + 4 * n);
#pragma unroll
        for (int ai = 0; ai < 2; ++ai)
#pragma unroll
            for (int m = 0; m < 4; ++m) { bf16_t* rowp = Yp + (size_t)(row0 + ai * HALF + m * 16) * D + col0;
#pragma unroll
                for (int bj = 0; bj < 2; ++bj) *(u32x4*)(rowp + bj * HALF) = pack8(acc[ai][bj][m][0] + bv[bj][0], acc[ai][bj][m][1] + bv[bj][1]); }
    }
};
struct EpiGate {
    static constexpr bool PERM = false, AFTER_DRAIN = false, HAS_MID = false;
    const float* H; const bf16_t* PR; float* OUT;
    __device__ __forceinline__ void operator()(const f32x4 (&acc)[2][2][4][2], const Unit& u, int wr, int wc, int fr, int fq) const {
        const int row0 = u.pm * BM + wr * 64 + fr, col0 = u.pn * BM + wc * 32 + 4 * fq;
#pragma unroll
        for (int ai = 0; ai < 2; ++ai)
#pragma unroll
            for (int m = 0; m < 4; ++m) { const size_t off = (size_t)(row0 + ai * HALF + m * 16) * D + col0;
#pragma unroll
                for (int bj = 0; bj < 2; ++bj)
#pragma unroll
                    for (int n = 0; n < 2; ++n) { const size_t o2 = off + bj * HALF + n * 16; const f32x4 hv = *(const f32x4*)(H + o2); const u32x2 pw = *(const u32x2*)(PR + o2); const f32x4 a = acc[ai][bj][m][n];
                        f32x4 r;
                        r[0] = hv[0] + __builtin_amdgcn_rcpf(1.0f + __builtin_amdgcn_exp2f(-LOG2E * a[0])) * __uint_as_float(pw.x << 16);
                        r[1] = hv[1] + __builtin_amdgcn_rcpf(1.0f + __builtin_amdgcn_exp2f(-LOG2E * a[1])) * __uint_as_float(pw.x & 0xffff0000u);
                        r[2] = hv[2] + __builtin_amdgcn_rcpf(1.0f + __builtin_amdgcn_exp2f(-LOG2E * a[2])) * __uint_as_float(pw.y << 16);
                        r[3] = hv[3] + __builtin_amdgcn_rcpf(1.0f + __builtin_amdgcn_exp2f(-LOG2E * a[3])) * __uint_as_float(pw.y & 0xffff0000u);
                        *(f32x4*)(OUT + o2) = r; } }
    }
};

template <class Epi, class Sched, bool ALIGN_EPI>
__device__ __forceinline__ void gemm_phase(PG8_LAS unsigned char* lds, int wave_id, const Gemm g, const Sched& S, const Epi& E) {
    const int wid = wave_id, lane = lane_id(), tid = wid * 64 + lane, wr = wid >> 2, wc = wid & 3, fr = lane & 15, fq = lane >> 4;
    const int K = g.K, nt = K / BK;
    unsigned voffA[2], voffB[2];
#pragma unroll
    for (int i = 0; i < 2; ++i) { int R, C; stage_rc(tid * 16 + i * 8192, R, C); const int Rb = Epi::PERM ? ((R & ~31) + perm32(R & 31)) : R;
        voffA[i] = (unsigned)(R * g.lda + C) * 2u; voffB[i] = (unsigned)(Rb * g.ldb + C) * 2u; }
    const size_t kstep = (size_t)(BK * 2);
    const size_t hstepA = (size_t)HALF * g.lda * 2, hstepB = (size_t)HALF * g.ldb * 2;
    const size_t tstepA = 2 * hstepA, tstepB = 2 * hstepB;
    const unsigned ldsw = (unsigned)wid * 1024u;
    const int aoff = lds_byte(wr * 64 + fr, fq * 8), boff = lds_byte(wc * 32 + fr, fq * 8);
#define PG8_SA(b, h) (((b) * 2 + (h)) * HTB)
#define PG8_SB(b, h) ((4 + (b) * 2 + (h)) * HTB)
#define PG8_STAGE(bufoff, gbase, voff) do { _Pragma("unroll") for (int _i = 0; _i < 2; ++_i) \
        __builtin_amdgcn_global_load_lds((const unsigned*)((const char*)(gbase) + (voff)[_i]), (PG8_LAS unsigned*)(lds + (bufoff) + ldsw + _i * 8192), 16, 0, 0); } while (0)
#define PG8_LDA(dst, b, h) do { _Pragma("unroll") for (int m = 0; m < 4; ++m) _Pragma("unroll") for (int k = 0; k < 2; ++k) dst[m][k] = *(const PG8_LAS bf16x8*)(lds + PG8_SA(b, h) + aoff + m * 2048 + k * 1024); } while (0)
#define PG8_LDB(dst, b, h) do { _Pragma("unroll") for (int n = 0; n < 2; ++n) _Pragma("unroll") for (int k = 0; k < 2; ++k) dst[n][k] = *(const PG8_LAS bf16x8*)(lds + PG8_SB(b, h) + boff + n * 2048 + k * 1024); } while (0)
#define PG8_MMA(ai, bj, At, Bt) do { __builtin_amdgcn_s_setprio(1); _Pragma("unroll") for (int m = 0; m < 4; ++m) _Pragma("unroll") for (int n = 0; n < 2; ++n) _Pragma("unroll") for (int k = 0; k < 2; ++k) \
        acc[ai][bj][m][n] = __builtin_amdgcn_mfma_f32_16x16x32_bf16(Bt[n][k], At[m][k], acc[ai][bj][m][n], 0, 0, 0); __builtin_amdgcn_s_setprio(0); } while (0)
#define PG8_WAIT_V(n) asm volatile("s_waitcnt vmcnt(" #n ")" ::: "memory")
#define PG8_WAIT_L(n) asm volatile("s_waitcnt lgkmcnt(" #n ")" ::: "memory")
#define PG8_BAR __builtin_amdgcn_s_barrier()
#define PG8_SCHED __builtin_amdgcn_sched_barrier(0)
    Unit cur, nxt; int ui = 0;
    if (!S.next(0, cur)) return;
    f32x4 acc[2][2][4][2];
#pragma unroll
    for (int a = 0; a < 2; ++a)
#pragma unroll
        for (int b = 0; b < 2; ++b)
#pragma unroll
            for (int m = 0; m < 4; ++m)
#pragma unroll
                for (int n = 0; n < 2; ++n) acc[a][b][m][n] = (f32x4){0.f, 0.f, 0.f, 0.f};
    bf16x8 At[4][2], B0[2][2], B1[2][2];
    const char* cA = (const char*)g.A + (size_t)cur.pm * tstepA; const char* cB = (const char*)g.Bt + (size_t)cur.pb * tstepB;
    if constexpr (Epi::HAS_MID) E.begin(cur, tid);
    PG8_STAGE(PG8_SB(0, 0), cB, voffB); PG8_STAGE(PG8_SB(0, 1), cB + hstepB, voffB); PG8_STAGE(PG8_SA(0, 0), cA, voffA); PG8_STAGE(PG8_SA(0, 1), cA + hstepA, voffA);
    if (wr == 1) PG8_BAR;
    PG8_WAIT_V(2); PG8_BAR;
    PG8_STAGE(PG8_SB(1, 0), cB + kstep, voffB); PG8_STAGE(PG8_SA(1, 0), cA + kstep, voffA); PG8_STAGE(PG8_SB(1, 1), cB + hstepB + kstep, voffB);
    PG8_WAIT_V(6); PG8_BAR;
    for (;;) {
        const bool has_next = S.next(ui + 1, nxt);
        const char* nA = has_next ? (const char*)g.A + (size_t)nxt.pm * tstepA : cA; const char* nB = has_next ? (const char*)g.Bt + (size_t)nxt.pb * tstepB : cB;
        for (int t = 0; t < nt; t += 2) {
            const bool last = (t == nt - 2);
            const char* a1 = cA + (size_t)(t + 1) * kstep;
            const char* a2 = last ? nA : cA + (size_t)(t + 2) * kstep; const char* b2 = last ? nB : cB + (size_t)(t + 2) * kstep;
            const char* a3 = a2 + kstep; const char* b3 = b2 + kstep;
            if constexpr (Epi::HAS_MID) { if (t == nt / 2) E.mid(acc, wr, lane_id() & 15); }
            PG8_LDB(B0, 0, 0); PG8_LDB(B1, 0, 1); PG8_SCHED; PG8_LDA(At, 0, 0); PG8_STAGE(PG8_SA(1, 1), a1 + hstepA, voffA);
            PG8_WAIT_V(8); PG8_WAIT_L(0); PG8_BAR; PG8_MMA(0, 0, At, B0); PG8_MMA(0, 1, At, B1); PG8_BAR; PG8_SCHED;
            PG8_LDA(At, 0, 1); PG8_STAGE(PG8_SB(0, 0), b2, voffB); PG8_STAGE(PG8_SB(0, 1), b2 + hstepB, voffB); PG8_STAGE(PG8_SA(0, 0), a2, voffA);
            PG8_WAIT_V(8); PG8_WAIT_L(0); PG8_BAR; PG8_MMA(1, 0, At, B0); PG8_MMA(1, 1, At, B1); PG8_BAR; PG8_SCHED;
            PG8_LDB(B0, 1, 0); PG8_LDB(B1, 1, 1); PG8_SCHED; PG8_LDA(At, 1, 0); PG8_STAGE(PG8_SA(0, 1), a2 + hstepA, voffA);
            PG8_WAIT_V(8); PG8_WAIT_L(0); PG8_BAR; PG8_MMA(0, 0, At, B0); PG8_MMA(0, 1, At, B1); PG8_BAR; PG8_SCHED;
            PG8_LDA(At, 1, 1); PG8_STAGE(PG8_SB(1, 0), b3, voffB); PG8_STAGE(PG8_SB(1, 1), b3 + hstepB, voffB); PG8_STAGE(PG8_SA(1, 0), a3, voffA);
            PG8_WAIT_V(8); PG8_WAIT_L(0); PG8_BAR; PG8_MMA(1, 0, At, B0); PG8_MMA(1, 1, At, B1); PG8_BAR; PG8_SCHED;
        }
        if constexpr (ALIGN_EPI) { if (wr == 0) PG8_BAR; }
        { const int l2 = lane_id();
          E(acc, cur, wr, wc, l2 & 15, l2 >> 4); }
        if (!has_next) break;
#pragma unroll
        for (int a = 0; a < 2; ++a)
#pragma unroll
            for (int b = 0; b < 2; ++b)
#pragma unroll
                for (int m = 0; m < 4; ++m)
#pragma unroll
                    for (int n = 0; n < 2; ++n) acc[a][b][m][n] = (f32x4){0.f, 0.f, 0.f, 0.f};
        cur = nxt; cA = nA; cB = nB; ++ui;
        if constexpr (ALIGN_EPI) { if (wr == 1) PG8_BAR; }
    }
    PG8_WAIT_V(0);
    if constexpr (!ALIGN_EPI) { if (wr == 0) PG8_BAR; }
    PG8_BAR;
#undef PG8_SA
#undef PG8_SB
#undef PG8_STAGE
#undef PG8_LDA
#undef PG8_LDB
#undef PG8_MMA
#undef PG8_WAIT_V
#undef PG8_WAIT_L
#undef PG8_BAR
#undef PG8_SCHED
}
}

namespace att {
typedef short bf16x8 __attribute__((ext_vector_type(8)));
typedef short s16x4 __attribute__((ext_vector_type(4)));
typedef float f32x16 __attribute__((ext_vector_type(16)));
typedef __attribute__((address_space(3))) const char* lds_cptr;
constexpr int KSLOT = 12288, VSLOT = 8192, LDS_K = 0, LDS_V = 3 * KSLOT, LDS_WS = LDS_V + 3 * VSLOT, LDS_OST = LDS_WS + 8 * 256, LDS_FLAG = LDS_OST + 8 * 4096, ATT_BYTES = LDS_FLAG + 64;
static_assert(ATT_BYTES <= RING_BYTES, "attention LDS");
__device__ __forceinline__ int crow(int r, int hi) { return (r & 3) + 8 * (r >> 2) + 4 * hi; }
__device__ __forceinline__ void glds16(const void* gsrc, unsigned lds_dst) { unsigned keep;
    asm volatile("s_mov_b32 %0, m0\n\ts_mov_b32 m0, %2\n\ts_nop 0\n\tglobal_load_lds_dwordx4 %1, off\n\ts_mov_b32 m0, %0" : "=&s"(keep) : "v"(gsrc), "s"(lds_dst) : "memory"); }
__device__ __forceinline__ s16x4 vtr(lds_cptr p) { typedef short v4i16_t __attribute__((ext_vector_type(4))); return __builtin_bit_cast(s16x4, __builtin_amdgcn_ds_read_tr16_b64_v4i16((__attribute__((address_space(3))) v4i16_t*)p)); }
__device__ __forceinline__ float swap32(float x) { const unsigned u = __float_as_uint(x); auto rr = __builtin_amdgcn_permlane32_swap(u, u, false, false); return __uint_as_float(rr[0] ^ rr[1] ^ u); }
__device__ __forceinline__ bf16x8 pack8(const f32x16& p, int b) { pg8::u32x4 w; w.x = pg8::cvt_pk_bf16(p[b], p[b + 1]); w.y = pg8::cvt_pk_bf16(p[b + 2], p[b + 3]); w.z = pg8::cvt_pk_bf16(p[b + 4], p[b + 5]); w.w = pg8::cvt_pk_bf16(p[b + 6], p[b + 7]); return __builtin_bit_cast(bf16x8, w); }
#define ATT_WAIT_BAR(N) asm volatile("s_waitcnt vmcnt(" #N ") lgkmcnt(0)\n\ts_barrier" ::: "memory")
__device__ __forceinline__ void pv(f32x16 (&o)[2], lds_cptr vp, const bf16x8 (&pa)[4]) {
#pragma unroll
    for (int d0 = 0; d0 < 2; ++d0)
#pragma unroll
        for (int ks = 0; ks < 4; ++ks) { const s16x4 lo = vtr(vp + d0 * 4096 + ks * 1024), hi = vtr(vp + d0 * 4096 + ks * 1024 + 512);
            const bf16x8 vb = (bf16x8){lo[0], lo[1], lo[2], lo[3], hi[0], hi[1], hi[2], hi[3]};
            o[d0] = __builtin_amdgcn_mfma_f32_32x32x16_bf16(pa[ks], vb, o[d0], 0, 0, 0); }
}
__device__ __forceinline__ void store_o(const f32x16 (&o)[2], const float (&rsc)[16], bf16* Ow, int pitch, float* POw, int pslot, LAS unsigned char* shm, int wid, int lane) {
    const int r32 = lane & 31, hi = lane >> 5;
    LAS bf16* stg = (LAS bf16*)(shm + LDS_OST + wid * 4096);
#pragma unroll
    for (int r = 0; r < 16; ++r) { const int orow = crow(r, hi);
#pragma unroll
        for (int d0 = 0; d0 < 2; ++d0) stg[orow * 64 + d0 * 32 + r32] = (bf16)f2bf(o[d0][r] * rsc[r]); }
    asm volatile("s_waitcnt lgkmcnt(0)" ::: "memory");
#pragma unroll
    for (int i = 0; i < 4; ++i) { const int row = i * 8 + (lane >> 3), ch = lane & 7; const v4u v = *(const LAS v4u*)(stg + row * 64 + ch * 8);
        *(GAS v4u*)(Ow + (size_t)row * pitch + ch * 8) = v;
        float s = 0.f;
#pragma unroll
        for (int j = 0; j < 4; ++j) { const float a = bflo(v[j]), b = bfhi(v[j]); s += a * a + b * b; }
        s += __shfl_xor(s, 1); s += __shfl_xor(s, 2); s += __shfl_xor(s, 4);
        if (ch == 0) POw[(size_t)row * 16 + pslot] = s; }
}

__device__ __forceinline__ void mla_unit(Frame& F, int b, int h, int qb, LAS unsigned char* shm) {
    const int wid = F.wave, lane = lane_id(), r32 = lane & 31, hi = lane >> 5;
    const long rowbase = (long)b * SEQ; const int q0 = qb * 256;
    const unsigned lds0 = (unsigned)(uintptr_t)shm;
    LAS float* wsf = (LAS float*)(shm + LDS_WS) + wid * 64;
    const bf16* ksrc = F.KN + (rowbase + lane) * 512 + h * 64 + wid * 8;
    const bf16* rsrc = F.Y1 + (rowbase + lane) * NINP + C_KR + (wid & 3) * 8;
    const bf16* vsrc = F.VM + (rowbase + 16 * (wid & 3) + (lane >> 2)) * 512 + h * 64 + (wid >> 2) * 32 + (lane & 3) * 8;
    const unsigned kdst = lds0 + LDS_K + wid * 1024, rdst = lds0 + LDS_K + (8 + (wid & 3)) * 1024, vdst = lds0 + LDS_V + wid * 1024;
#define MLA_DMA(t, sl) do { glds16(ksrc + (long)(t) * 64 * 512, (unsigned)__builtin_amdgcn_readfirstlane(kdst + (sl) * KSLOT)); glds16(rsrc + (long)(t) * 64 * NINP, (unsigned)__builtin_amdgcn_readfirstlane(rdst + (sl) * KSLOT)); \
        glds16(vsrc + (long)(t) * 64 * 512, (unsigned)__builtin_amdgcn_readfirstlane(vdst + (sl) * VSLOT)); } while (0)
    const int NT = 4 * qb + 4, tl = 4 * qb + (wid >> 1);
    MLA_DMA(0, 0); MLA_DMA(1, 1);
    const bf16* Qw = F.Q + (rowbase + q0 + wid * 32 + r32) * (HM * QKD) + h * QKD + hi * 8;
    bf16x8 qr[6];
#pragma unroll
    for (int d0 = 0; d0 < 6; ++d0) qr[d0] = *(const GAS bf16x8*)(Qw + d0 * 16);
    float m = -1e30f, l = 0.f; f32x16 o[2]; o[0] = f32x16{}; o[1] = f32x16{};
    const int qrel = (wid & 1) * 32 + r32;
    const lds_cptr shm3 = (lds_cptr)shm; const lds_cptr kp0 = shm3 + LDS_K + hi * 1024 + r32 * 16, vp0 = shm3 + LDS_V + ((lane >> 4) & 1) * 32 + (lane & 3) * 8 + (4 * hi + ((lane & 15) >> 2)) * 64;
    int sl = 0, sl2 = 2;
    for (int t = 0; t < NT; ++t) {
        if (t + 1 < NT) ATT_WAIT_BAR(3); else ATT_WAIT_BAR(0);
        if (t + 2 < NT) MLA_DMA(t + 2, sl2);
        if (t <= tl) {
            const lds_cptr kp = kp0 + sl * KSLOT;
            f32x16 p0 = f32x16{}, p1 = f32x16{};
#pragma unroll
            for (int d0 = 0; d0 < 6; ++d0) { const bf16x8 k0 = *(const __attribute__((address_space(3))) bf16x8*)(kp + d0 * 2048), k1 = *(const __attribute__((address_space(3))) bf16x8*)(kp + d0 * 2048 + 512);
                p0 = __builtin_amdgcn_mfma_f32_32x32x16_bf16(k0, qr[d0], p0, 0, 0, 0); p1 = __builtin_amdgcn_mfma_f32_32x32x16_bf16(k1, qr[d0], p1, 0, 0, 0); }
            if (t == tl) {
#pragma unroll
                for (int r = 0; r < 16; ++r) { const int kv = crow(r, hi); if (kv > qrel) p0[r] = -INFINITY; if (kv + 32 > qrel) p1[r] = -INFINITY; }
            }
            float rm = fmaxf(p0[0], p1[0]);
#pragma unroll
            for (int r = 1; r < 16; ++r) rm = fmaxf(rm, fmaxf(p0[r], p1[r]));
            rm = fmaxf(rm, swap32(rm));
            if (__any(rm > m + 8.0f)) {
                const float mn = fmaxf(m, rm), al = __builtin_amdgcn_exp2f(m - mn); m = mn; l *= al;
                if (hi == 0) wsf[r32] = al;
                asm volatile("s_waitcnt lgkmcnt(0)" ::: "memory");
#pragma unroll
                for (int r = 0; r < 16; ++r) { const float f = wsf[crow(r, hi)]; o[0][r] *= f; o[1][r] *= f; }
            }
            float ls = 0.f;
#pragma unroll
            for (int r = 0; r < 16; ++r) { p0[r] = __builtin_amdgcn_exp2f(p0[r] - m); p1[r] = __builtin_amdgcn_exp2f(p1[r] - m); ls += p0[r] + p1[r]; }
            l += ls;
            const bf16x8 pa[4] = {pack8(p0, 0), pack8(p0, 8), pack8(p1, 0), pack8(p1, 8)};
            pv(o, vp0 + sl * VSLOT, pa);
        }
        sl = (sl == 2) ? 0 : sl + 1; sl2 = (sl2 == 2) ? 0 : sl2 + 1;
    }
#undef MLA_DMA
    l += swap32(l);
    if (hi == 0) wsf[32 + r32] = l;
    asm volatile("s_waitcnt lgkmcnt(0)" ::: "memory");
    float rli[16];
#pragma unroll
    for (int r = 0; r < 16; ++r) rli[r] = __builtin_amdgcn_rcpf(wsf[32 + crow(r, hi)]);
    const long orow0 = rowbase + q0 + wid * 32;
    store_o(o, rli, F.O + orow0 * D + h * 64, D, F.PO + orow0 * 16, h, shm, wid, lane);
    asm volatile("s_waitcnt vmcnt(0) lgkmcnt(0)\n\ts_barrier" ::: "memory");
}

__device__ __forceinline__ void sb_unit(Frame& F, int b, int h, int qb, LAS unsigned char* shm) {
    const int wid = F.wave, lane = lane_id(), r32 = lane & 31, hi = lane >> 5;
    const long rowbase = (long)b * SEQ; const int q0 = qb * 256;
    const unsigned lds0 = (unsigned)(uintptr_t)shm;
    volatile LAS unsigned* flags = (volatile LAS unsigned*)(shm + LDS_FLAG);
    const bf16* ksrc = F.Y1 + (rowbase + lane) * NINP + C_KS + h * 64 + wid * 8;
    const bf16* vsrc = F.Y1 + (rowbase + 16 * (wid & 3) + (lane >> 2)) * NINP + C_VS + h * 64 + (wid >> 2) * 32 + (lane & 3) * 8;
    const unsigned kdst = lds0 + LDS_K + wid * 1024, vdst = lds0 + LDS_V + wid * 1024;
#define SB_DMA(t, sl) do { glds16(ksrc + (long)(t) * 64 * NINP, (unsigned)__builtin_amdgcn_readfirstlane(kdst + (sl) * KSLOT)); glds16(vsrc + (long)(t) * 64 * NINP, (unsigned)__builtin_amdgcn_readfirstlane(vdst + (sl) * VSLOT)); } while (0)
    const int NT = 4 * qb + 4, tl = 4 * qb + (wid >> 1);
    if (wid == 0 && lane < 3) flags[lane] = 0u;
    SB_DMA(NT - 1, 0); SB_DMA(NT - 2, 1);
    const bf16* Qw = F.Y1 + (rowbase + q0 + wid * 32 + r32) * NINP + C_QS + h * 64 + hi * 8;
    bf16x8 qr[4];
#pragma unroll
    for (int d0 = 0; d0 < 4; ++d0) qr[d0] = *(const GAS bf16x8*)(Qw + d0 * 16);
    float carry = 0.f; f32x16 o[2]; o[0] = f32x16{}; o[1] = f32x16{};
    const int qrel = (wid & 1) * 32 + r32;
    const lds_cptr shm3 = (lds_cptr)shm; const lds_cptr kp0 = shm3 + LDS_K + hi * 1024 + r32 * 16, vp0 = shm3 + LDS_V + ((lane >> 4) & 1) * 32 + (lane & 3) * 8 + (4 * hi + ((lane & 15) >> 2)) * 64;
    int sl = 0, sl2 = 2, f0 = 0;
    bool done = false;
    for (int i = 0; i < NT; ++i) {
        const int t = NT - 1 - i;
        if (i + 1 < NT) ATT_WAIT_BAR(2); else ATT_WAIT_BAR(0);
        if (i > 0) { const int fp = (f0 == 0) ? 2 : f0 - 1; if (flags[fp] == 0u) break; }
        { const int fn = (f0 == 2) ? 0 : f0 + 1; if (wid == 0 && lane == 0) flags[fn] = 0u; }
        if (i + 2 < NT) SB_DMA(t - 2, sl2);
        if (t <= tl && !done) {
            const lds_cptr kp = kp0 + sl * KSLOT;
            f32x16 z0 = f32x16{}, z1 = f32x16{};
#pragma unroll
            for (int d0 = 0; d0 < 4; ++d0) { const bf16x8 k0 = *(const __attribute__((address_space(3))) bf16x8*)(kp + d0 * 2048), k1 = *(const __attribute__((address_space(3))) bf16x8*)(kp + d0 * 2048 + 512);
                z0 = __builtin_amdgcn_mfma_f32_32x32x16_bf16(k0, qr[d0], z0, 0, 0, 0); z1 = __builtin_amdgcn_mfma_f32_32x32x16_bf16(k1, qr[d0], z1, 0, 0, 0); }
            f32x16 s0, s1;
#pragma unroll
            for (int r = 0; r < 16; ++r) { s0[r] = fmaxf(z0[r], 0.f) + __builtin_amdgcn_logf(1.0f + __builtin_amdgcn_exp2f(-fabsf(z0[r]))); s1[r] = fmaxf(z1[r], 0.f) + __builtin_amdgcn_logf(1.0f + __builtin_amdgcn_exp2f(-fabsf(z1[r]))); }
            const bool diag = (t == tl);
            if (diag) {
#pragma unroll
                for (int r = 0; r < 16; ++r) { const int kv = crow(r, hi); if (kv >= qrel) s0[r] = 0.f; if (kv + 32 >= qrel) s1[r] = 0.f; }
            }
            float own[8], part[8], R[8];
#pragma unroll
            for (int g = 0; g < 4; ++g) { own[g] = (s0[4 * g] + s0[4 * g + 1]) + (s0[4 * g + 2] + s0[4 * g + 3]); own[4 + g] = (s1[4 * g] + s1[4 * g + 1]) + (s1[4 * g + 2] + s1[4 * g + 3]); }
#pragma unroll
            for (int g = 0; g < 8; ++g) part[g] = swap32(own[g]);
            R[7] = 0.f;
#pragma unroll
            for (int g = 6; g >= 0; --g) R[g] = R[g + 1] + (own[g + 1] + part[g + 1]);
            const float total = R[0] + (own[0] + part[0]);
            f32x16 a0, a1;
#pragma unroll
            for (int g = 0; g < 4; ++g) {
                { const float base = carry - (R[g] + (hi == 0 ? part[g] : 0.f));
                  const float w3 = 0.f, w2 = s0[4 * g + 3], w1 = w2 + s0[4 * g + 2], w0 = w1 + s0[4 * g + 1];
                  a0[4 * g + 0] = __builtin_amdgcn_exp2f(z0[4 * g + 0] - s0[4 * g + 0] + (base - w0)); a0[4 * g + 1] = __builtin_amdgcn_exp2f(z0[4 * g + 1] - s0[4 * g + 1] + (base - w1));
                  a0[4 * g + 2] = __builtin_amdgcn_exp2f(z0[4 * g + 2] - s0[4 * g + 2] + (base - w2)); a0[4 * g + 3] = __builtin_amdgcn_exp2f(z0[4 * g + 3] - s0[4 * g + 3] + (base - w3)); }
                { const float base = carry - (R[4 + g] + (hi == 0 ? part[4 + g] : 0.f));
                  const float w3 = 0.f, w2 = s1[4 * g + 3], w1 = w2 + s1[4 * g + 2], w0 = w1 + s1[4 * g + 1];
                  a1[4 * g + 0] = __builtin_amdgcn_exp2f(z1[4 * g + 0] - s1[4 * g + 0] + (base - w0)); a1[4 * g + 1] = __builtin_amdgcn_exp2f(z1[4 * g + 1] - s1[4 * g + 1] + (base - w1));
                  a1[4 * g + 2] = __builtin_amdgcn_exp2f(z1[4 * g + 2] - s1[4 * g + 2] + (base - w2)); a1[4 * g + 3] = __builtin_amdgcn_exp2f(z1[4 * g + 3] - s1[4 * g + 3] + (base - w3)); }
            }
            if (diag) {
#pragma unroll
                for (int r = 0; r < 16; ++r) { const int kv = crow(r, hi); if (kv >= qrel) a0[r] = 0.f; if (kv + 32 >= qrel) a1[r] = 0.f; }
            }
            carry -= total;
            const bf16x8 pa[4] = {pack8(a0, 0), pack8(a0, 8), pack8(a1, 0), pack8(a1, 8)};
            pv(o, vp0 + sl * VSLOT, pa);
            done = __all(carry < SB_DONE);
        }
        if (!(t <= tl && done)) { if (lane == 0) flags[f0] = 1u; }
        sl = (sl == 2) ? 0 : sl + 1; sl2 = (sl2 == 2) ? 0 : sl2 + 1; f0 = (f0 == 2) ? 0 : f0 + 1;
    }
#undef SB_DMA
    float one[16];
#pragma unroll
    for (int r = 0; r < 16; ++r) one[r] = 1.0f;
    const long orow0 = rowbase + q0 + wid * 32;
    asm volatile("s_waitcnt vmcnt(0)" ::: "memory");
    store_o(o, one, F.O + orow0 * D + 512 + h * 64, D, F.PO + orow0 * 16, 8 + h, shm, wid, lane);
    asm volatile("s_waitcnt vmcnt(0) lgkmcnt(0)\n\ts_barrier" ::: "memory");
}
#undef ATT_WAIT_BAR
__device__ __forceinline__ void attn_phase(Frame& F, LAS unsigned char* shm) {
    const int bh = F.vcu >> 3, s = F.vcu & 7, b = bh >> 3, h = bh & 7;
    mla_unit(F, b, h, 15 - s, shm);
    mla_unit(F, b, h, s, shm);
    sb_unit(F, b, h, 15 - s, shm);
    sb_unit(F, b, h, s, shm);
}
}

__device__ __forceinline__ void p0_transpose_item(const float* W, int ldw, bf16* WT, int ldt, int k0, int nsrc0, int ndst0, int mode, const float* gk, float sc, LAS float* scr, int lane) {
#pragma unroll 8
    for (int i = 0; i < 32; ++i) { const int kk = 2 * i + (lane >> 5); const float g = gk ? gk[k0 + kk] * sc : sc; scr[kk * 33 + (lane & 31)] = W[(size_t)(k0 + kk) * ldw + nsrc0 + (lane & 31)] * g; }
    asm volatile("s_waitcnt lgkmcnt(0)" ::: "memory");
    const int c = lane & 7;
#pragma unroll
    for (int j = 0; j < 4; ++j) { const int n = (lane >> 3) + 8 * j; const LAS float* s = scr + (8 * c) * 33 + n;
        v4u o; o.x = pk2(s[0 * 33], s[1 * 33]); o.y = pk2(s[2 * 33], s[3 * 33]); o.z = pk2(s[4 * 33], s[5 * 33]); o.w = pk2(s[6 * 33], s[7 * 33]);
        const int nd = mode ? (2 * (n & 15) + (n >> 4)) : n;
        *(GAS v4u*)(WT + (size_t)(ndst0 + nd) * ldt + k0 + 8 * c) = o; }
    asm volatile("s_waitcnt lgkmcnt(0)" ::: "memory");
}
__device__ __forceinline__ void p0_weights(Frame& F) {
    LAS float* scr = (LAS float*)(F.lds + RING_OFF + F.wave * 16384);
    const int gw = F.vcu * NWAVES + F.wave, NGW = F.G * NWAVES, lane = F.lane;
    constexpr int I_IN = (D / 64) * (NIN / 32), I_UQ = (QLR / 64) * (HM * QKD / 32), I_UKV = (KVLR / 64) * (HM * 128 / 32), I_O = (D / 64) * (D / 32), I_PG = I_O, I_PP = (PLE / 64) * (D / 32);
    constexpr int I_GU1 = (D / 64) * (2 * DFF / 32), I_DN1 = (DFF / 64) * (D / 32);
    constexpr int I_SMALL = I_IN + I_UQ + I_UKV + I_O + I_PG + I_PP, NITEMS = I_SMALL + NE * (I_GU1 + I_DN1);
    bf16* WIN = (bf16*)(F.ws + WS_WIN); bf16* WUQ = (bf16*)(F.ws + WS_WUQ); bf16* WUKV = (bf16*)(F.ws + WS_WUKV); bf16* WO = (bf16*)(F.ws + WS_WO); bf16* WPG = (bf16*)(F.ws + WS_WPG); bf16* WPP = (bf16*)(F.ws + WS_WPP);
    bf16* WGU = (bf16*)(F.ws + WS_WGU); bf16* WDN = (bf16*)(F.ws + WS_WDN);
    for (int it = gw; it < NITEMS; it += NGW) {
        int r = it;
        if (r < I_IN) { const int nb = NIN / 32, kb = r / nb, n0 = 32 * (r % nb); const float sc = (n0 >= C_QS && n0 < C_KS) ? QS_SCALE : 1.0f;
            p0_transpose_item(F.w_in, NIN, WIN, D, 64 * kb, n0, n0, n0 == C_KR, F.g_attn, sc, scr, lane); continue; } r -= I_IN;
        if (r < I_UQ) { const int nb = HM * QKD / 32, kb = r / nb, n0 = 32 * (r % nb);
            p0_transpose_item(F.w_uq, HM * QKD, WUQ, QLR, 64 * kb, n0, n0, (n0 % QKD) == NOPE, F.g_cq, Q_SCALE, scr, lane); continue; } r -= I_UQ;
        if (r < I_UKV) { const int nb = HM * 128 / 32, kb = r / nb, n0 = 32 * (r % nb); const int h = n0 / 128, w = n0 % 128; const int nd = (w < 64) ? h * 64 + w : 512 + h * 64 + (w - 64);
            p0_transpose_item(F.w_ukv, HM * 128, WUKV, KVLR, 64 * kb, n0, nd, 0, F.g_ckv, 1.0f, scr, lane); continue; } r -= I_UKV;
        if (r < I_O) { const int nb = D / 32, kb = r / nb, n0 = 32 * (r % nb); const int k0 = 64 * kb;
            p0_transpose_item(F.w_o, D, WO, D, k0, n0, n0, 0, (k0 < 512) ? F.g_out_mla : F.g_out_sb - 512, 1.0f, scr, lane); continue; } r -= I_O;
        if (r < I_PG) { const int nb = D / 32, kb = r / nb, n0 = 32 * (r % nb);
            p0_transpose_item(F.w_ple_gate, D, WPG, D, 64 * kb, n0, n0, 0, F.g_ple, 1.0f, scr, lane); continue; } r -= I_PG;
        if (r < I_PP) { const int nb = D / 32, kb = r / nb, n0 = 32 * (r % nb);
            p0_transpose_item(F.w_ple_proj, D, WPP, PLE, 64 * kb, n0, n0, 0, nullptr, 1.0f, scr, lane); continue; } r -= I_PP;
        const int e = r / (I_GU1 + I_DN1); r -= e * (I_GU1 + I_DN1);
        if (r < I_GU1) { const int nb = 2 * DFF / 32, kb = r / nb, n0 = 32 * (r % nb); const int nn = n0 & (DFF - 1); const int nd = (nn >> 7) * 256 + ((n0 >= DFF) ? 128 : 0) + (nn & 127);
            p0_transpose_item(F.w_gu + (size_t)e * D * 2 * DFF, 2 * DFF, WGU + (size_t)e * 2 * DFF * D, D, 64 * kb, n0, nd, 0, F.g_moe, 1.0f, scr, lane); continue; } r -= I_GU1;
        { const int nb = D / 32, kb = r / nb, n0 = 32 * (r % nb);
            p0_transpose_item(F.w_dn + (size_t)e * DFF * D, D, WDN + (size_t)e * D * DFF, DFF, 64 * kb, n0, n0, 0, nullptr, 1.0f, scr, lane); }
    }
    const int gt = blockIdx.x * NTHR + F.tid, NT = F.G * NTHR;
    for (int i = gt; i < (NINP - NIN) * D / 8; i += NT) ((GAS v4u*)(WIN + (size_t)NIN * D))[i] = (v4u){0u, 0u, 0u, 0u};
}

constexpr int N_PHASES = 13;
struct Args { const void* in[23]; float* out; unsigned char* ws; int ph_lo, ph_hi; };
__global__ void __launch_bounds__(NTHR, 2) mega_fwd(Args args) {
    extern __shared__ __attribute__((aligned(16))) unsigned char lds[];
    Frame F;
    F.lds = (LAS unsigned char*)lds;
    F.MISC = (volatile LAS unsigned*)(F.lds + MISC_OFF);
    F.tid = threadIdx.x; F.lane = F.tid & 63; F.wave = __builtin_amdgcn_readfirstlane(F.tid >> 6);
    F.G = gridDim.x; { const int bx = blockIdx.x; F.vcu = (F.G % 8 == 0) ? (bx % 8) * (F.G / 8) + bx / 8 : bx; }
    unsigned char* ws = args.ws; F.ws = ws;
    F.ctl = (gu32*)(ws + WS_CTL); F.PA = (float*)(ws + WS_PARTA); F.PO = (float*)(ws + WS_PARTO);
    F.x = (const float*)args.in[0]; F.p = (const float*)args.in[1]; F.pos = (const int*)args.in[2];
    F.w_in = (const float*)args.in[3]; F.g_attn = (const float*)args.in[4]; F.g_cq = (const float*)args.in[5]; F.w_uq = (const float*)args.in[6]; F.g_ckv = (const float*)args.in[7];
    F.w_ukv = (const float*)args.in[8]; F.g_out_mla = (const float*)args.in[9]; F.g_out_sb = (const float*)args.in[10]; F.w_o = (const float*)args.in[11]; F.g_moe = (const float*)args.in[12];
    F.w_router = (const float*)args.in[13]; F.b_router = (const float*)args.in[14]; F.w_gu = (const float*)args.in[15]; F.b_gu = (const float*)args.in[16]; F.w_dn = (const float*)args.in[17];
    F.b_dn = (const float*)args.in[18]; F.g_ple = (const float*)args.in[19]; F.w_ple_gate = (const float*)args.in[20]; F.w_ple_proj = (const float*)args.in[21]; F.g_final = (const float*)args.in[22];
    F.out = args.out;
    F.XN = (bf16*)(ws + WS_XN); F.Y1 = (bf16*)(ws + WS_Y1); F.Q = (bf16*)(ws + WS_Q); F.KN = (bf16*)(ws + WS_KN); F.VM = (bf16*)(ws + WS_VM); F.O = (bf16*)(ws + WS_O);
    F.PBF = (bf16*)(ws + WS_PBF); F.PROJ = (bf16*)(ws + WS_PROJ); F.XG = (bf16*)(ws + WS_XG); F.ACT = (bf16*)(ws + WS_ACT); F.Yb = (bf16*)(ws + WS_XG);
    F.H1 = (float*)(ws + WS_H1); F.COS = (float*)(ws + WS_CS); F.SIN = (float*)(ws + WS_CS + MiB);
    F.topk_e = (int*)(ws + WS_ROUTE); F.gate = (float*)(ws + WS_ROUTE + 256 * 1024); F.lpos = (int*)(ws + WS_ROUTE + 512 * 1024); F.slot = (int*)(ws + WS_ROUTE + 768 * 1024);
    for (int u = F.tid; u < (LDS_BYTES - LDSCTL_OFF) / 4; u += NTHR) ((LAS unsigned*)(F.lds + LDSCTL_OFF))[u] = 0u;
    __syncthreads();
    const int lo = args.ph_lo, hi = args.ph_hi;
    const bool one = (hi - lo) > 1;
    XcdBarrier bar; bar.bar = (unsigned*)(F.ctl + CW_BAR); bar.x = 0; bar.st = nullptr;
    if (one) bar = xcd_barrier_post((unsigned*)(F.ctl + CW_BAR), F.MISC + 8);
#define IN(k) (F.lane = lane_id(), F.tid = F.wave * 64 + F.lane, lo <= (k) && (k) < hi)
#define SEAM(k) do { if (IN(k) && IN((k) + 1)) xcd_barrier(bar, F.wave); } while (0)
    bf16* const WIN = (bf16*)(ws + WS_WIN); bf16* const WUQ = (bf16*)(ws + WS_WUQ); bf16* const WUKV = (bf16*)(ws + WS_WUKV); bf16* const WO = (bf16*)(ws + WS_WO); bf16* const WPG = (bf16*)(ws + WS_WPG); bf16* const WPP = (bf16*)(ws + WS_WPP);
    bf16* const WGU = (bf16*)(ws + WS_WGU); bf16* const WDN = (bf16*)(ws + WS_WDN);
    LAS unsigned char* const ring = F.lds + RING_OFF;
    const volatile LAS int* const tsp = (const volatile LAS int*)(F.lds + L_TSTART);
    const int bid = (int)blockIdx.x;
    if (IN(0)) { p0_prologue(F);
#if OPT_P1 || OPT_P3 || OPT_P5 || OPT_P8 || OPT_P9 || OPT_P11
        p0_weights(F);
#endif
    } SEAM(0);
    if (IN(1)) {
#if OPT_P1
        { pg8::Gemm g{F.XN, D, WIN, D, D}; pg8::StaticOrder S; S.init(T / 256, NINP / 256, F.G, bid); pg8::EpiInProj E{F.Y1, F.PA, F.COS, F.SIN};
          pg8::gemm_phase<pg8::EpiInProj, pg8::StaticOrder, true>(ring, F.wave, g, S, E); }
        { pg8::Gemm g{F.PBF, PLE, WPP, PLE, PLE}; pg8::StaticOrder S; S.init(T / 256, D / 256, F.G - 64, bid - 64); pg8::EpiStoreBf16 E{F.PROJ, D};
          pg8::gemm_phase<pg8::EpiStoreBf16, pg8::StaticOrder, true>(ring, F.wave, g, S, E); }
#else
        NE_InProj E{NIN}; naive_gemm(F, F.XN, D, T, E); NE_Proj E2{D}; naive_gemm(F, F.PBF, PLE, T, E2);
#endif
    } SEAM(1);
    if (IN(2)) {
#if !OPT_P1
        naive_rowssq(F);
#endif
    }
#if !OPT_P1
    SEAM(2);
#endif
    if (IN(3)) {
#if OPT_P3
        { pg8::Gemm g{F.Y1 + C_CQ, NINP, WUQ, QLR, QLR}; pg8::StaticOrder S; S.init(T / 256, HM * QKD / 256, F.G, bid); pg8::EpiQ E{F.Q, F.PA, F.COS, F.SIN};
          pg8::gemm_phase<pg8::EpiQ, pg8::StaticOrder, false>(ring, F.wave, g, S, E); }
        { pg8::Gemm g{F.Y1 + C_CKV, NINP, WUKV, KVLR, KVLR}; pg8::StaticOrder S; S.init(T / 256, HM * 128 / 256, F.G, bid); pg8::EpiKV E{F.KN, F.VM, F.PA};
          pg8::gemm_phase<pg8::EpiKV, pg8::StaticOrder, false>(ring, F.wave, g, S, E); }
#else
        NE_Q E{HM * QKD}; naive_gemm(F, F.Y1 + C_CQ, NINP, T, E); NE_KV E2{HM * 128}; naive_gemm(F, F.Y1 + C_CKV, NINP, T, E2);
#endif
    } SEAM(3);
    if (IN(4)) {
#if OPT_P4
        att::attn_phase(F, ring);
#else
        naive_attention(F);
#endif
    } SEAM(4);
    if (IN(5)) {
#if OPT_P5
        pg8::Gemm g{F.O, D, WO, D, D}; pg8::StaticOrder S; S.init(T / 256, D / 256, F.G, bid); pg8::EpiWo E{F.x, F.H1, F.PO, (LAS float*)(F.lds + L_ROWS), (LAS float*)(F.lds + L_ROWS + 1024)};
        pg8::gemm_phase<pg8::EpiWo, pg8::StaticOrder, false>(ring, F.wave, g, S, E);
#else
        NE_Wo E{D}; naive_gemm(F, F.O, D, T, E);
#endif
    } SEAM(5);
    if (IN(6)) { p5a_route(F); } SEAM(6);
    if (IN(7)) { p5b_gather(F); } SEAM(7);
    if (IN(8)) { if (!IN(7)) build_tstart(F);
#if OPT_P8
        pg8::Gemm g{F.XG, D, WGU, D, D}; pg8::GroupedOrder S; S.init(tsp[NE], 2 * DFF / 256, F.G, bid); S.ts = tsp; pg8::EpiGu E{F.ACT, F.b_gu};
        pg8::gemm_phase<pg8::EpiGu, pg8::GroupedOrder, true>(ring, F.wave, g, S, E);
#else
        NE_Gu E{DFF}; naive_gemm(F, F.XG, D, RPAD, E);
#endif
    } SEAM(8);
    if (IN(9)) { if (!IN(7)) build_tstart(F);
#if OPT_P9
        pg8::Gemm g{F.ACT, DFF, WDN, DFF, DFF}; pg8::GroupedOrder S; S.init(tsp[NE], D / 256, F.G, bid); S.ts = tsp; pg8::EpiDn E{F.Yb, F.b_dn};
        pg8::gemm_phase<pg8::EpiDn, pg8::GroupedOrder, true>(ring, F.wave, g, S, E);
#else
        NE_Dn E{D}; naive_gemm(F, F.ACT, DFF, RPAD, E);
#endif
    } SEAM(9);
    if (IN(10)) { p8_combine(F); } SEAM(10);
    if (IN(11)) {
#if OPT_P11
        pg8::Gemm g{F.XN, D, WPG, D, D}; pg8::StaticOrder S; S.init(T / 256, D / 256, F.G, bid); pg8::EpiGate E{F.H1, F.PROJ, F.out};
        pg8::gemm_phase<pg8::EpiGate, pg8::StaticOrder, false>(ring, F.wave, g, S, E);
#else
        NE_Gate E{D}; naive_gemm(F, F.XN, D, T, E);
#endif
    } SEAM(11);
    if (IN(12)) { p10_final(F); }
#undef IN
#undef SEAM
}

extern "C" void kernel_launch(void* const* d_in, const int* in_sizes, int n_in, void* d_out, int out_size, void* d_ws, size_t ws_size, hipStream_t stream) {
    static int grid = 0;
    if (grid == 0) {
        if (n_in != 23 || in_sizes[0] != T * D || out_size != T * D || ws_size < WS_END) { fprintf(stderr, "kernel_launch: unexpected shapes (n_in %d, in0 %d, out %d, ws %zu); nothing launched\n", n_in, n_in > 0 ? in_sizes[0] : -1, out_size, ws_size); grid = -1; return; }
        int dev = 0, cus = 0;
        if (hipGetDevice(&dev) != hipSuccess || hipDeviceGetAttribute(&cus, hipDeviceAttributeMultiprocessorCount, dev) != hipSuccess) { grid = -1; return; }
        if (hipFuncSetAttribute((const void*)mega_fwd, hipFuncAttributeMaxDynamicSharedMemorySize, LDS_BYTES) != hipSuccess) { fprintf(stderr, "kernel_launch: hipFuncSetAttribute failed\n"); grid = -1; return; }
        int per_cu = 0;
        if (hipOccupancyMaxActiveBlocksPerMultiprocessor(&per_cu, (const void*)mega_fwd, NTHR, LDS_BYTES) != hipSuccess || per_cu < 1) fprintf(stderr, "kernel_launch: occupancy query reports %d\n", per_cu);
        (void)hipGetLastError();
        grid = cus;
        if (grid != 256) fprintf(stderr, "kernel_launch: %d CUs (expected 256)\n", grid);
    }
    if (grid < 0) return;
    (void)hipMemsetAsync((char*)d_ws + WS_CTL, 0, CTL_ZERO_BYTES, stream);
    Args a{};
    for (int i = 0; i < 23; ++i) a.in[i] = d_in[i];
    a.out = (float*)d_out; a.ws = (unsigned char*)d_ws;
#if MK_ONE_LAUNCH
    a.ph_lo = 0; a.ph_hi = N_PHASES;
    hipLaunchKernelGGL(mega_fwd, dim3(grid), dim3(NTHR), LDS_BYTES, stream, a);
#else
    for (int ph = 0; ph < N_PHASES; ++ph) { a.ph_lo = ph; a.ph_hi = ph + 1; hipLaunchKernelGGL(mega_fwd, dim3(grid), dim3(NTHR), LDS_BYTES, stream, a); }
#endif
}
```

```cpp
#include <hip/hip_runtime.h>
#include <cstdio>
#include <cstdint>

#ifndef MK_ONE_LAUNCH
#define MK_ONE_LAUNCH 1
#endif
#ifndef PROBE_DBL
#define PROBE_DBL 0
#endif
#define OPT_ROW 1
#define OPT_P1 1
#define OPT_P3 1
#define OPT_P4 1
#define OPT_P5 1
#define OPT_P8 1
#define OPT_P9 1
#define OPT_P11 1

constexpr int BATCH = 4, SEQ = 4096, T = BATCH * SEQ, D = 1024;
constexpr int NIN = 2208, NINP = 2304;
constexpr int QLR = 384, KVLR = 256, ROPE = 32, NOPE = 64, VDIM = 64, HM = 8, HS = 8, SBD = 64, QKD = NOPE + ROPE;
constexpr int C_CQ = 0, C_CKV = 384, C_KR = 640, C_QS = 672, C_KS = 1184, C_VS = 1696;
constexpr int NE = 32, TOPK = 4, DFF = 1024, PLE = 256;
constexpr int RPAD = T * TOPK + NE * 256;
constexpr float EPS = 1e-6f;
constexpr float LOG2E = 1.4426950408889634f;
constexpr float Q_SCALE = 0.10206207261596577f * LOG2E;
constexpr float QS_SCALE = 0.125f * LOG2E;
constexpr float SB_DONE = -200.0f;

constexpr int NWAVES = 8, NTHR = NWAVES * 64;

constexpr size_t MiB = 1u << 20;
constexpr size_t WS_CTL = 0, CTL_ZERO_BYTES = 1 * MiB;
constexpr size_t WS_WIN = 1 * MiB, WS_WUQ = 6 * MiB, WS_WUKV = 7 * MiB, WS_WO = 8 * MiB, WS_WPG = 10 * MiB, WS_WPP = 12 * MiB;
constexpr size_t WS_ROUTE = 13 * MiB, WS_CS = 14 * MiB;
constexpr size_t WS_WGU = 16 * MiB, WS_WDN = 144 * MiB, WS_XN = 208 * MiB, WS_Y1 = 240 * MiB, WS_Q = 312 * MiB, WS_KN = 336 * MiB, WS_VM = 352 * MiB;
constexpr size_t WS_O = 368 * MiB, WS_H1 = 400 * MiB, WS_PBF = 464 * MiB, WS_PROJ = 472 * MiB, WS_XG = 504 * MiB, WS_ACT = 648 * MiB, WS_PARTA = 792 * MiB, WS_PARTO = 793 * MiB, WS_END = 796 * MiB;
constexpr int CW_TMO = 0, CW_CODE = 1, CW_BAR = 4096, CW_CNT = 8192, CW_SSQ = 16384;
constexpr int SSQ_CQ = 0, SSQ_CKV = 1, SSQ_OM = 2, SSQ_OS = 3, SSQ_FIN = 4;
static_assert((CW_SSQ + 5 * T) * 4 <= (int)CTL_ZERO_BYTES, "ctl");

constexpr int RING_OFF = 0, RING_BYTES = 131072;
constexpr int LDSCTL_OFF = RING_BYTES, MISC_OFF = LDSCTL_OFF + 320;
constexpr int L_TSTART = LDSCTL_OFF + 1024;
constexpr int L_LCNT = LDSCTL_OFF + 1280;
constexpr int L_RSCR = LDSCTL_OFF + 2048;
constexpr int L_ARGS = LDSCTL_OFF + 6144;
constexpr int L_ROWS = LDSCTL_OFF + 4096;
constexpr int LDS_BYTES = 147456;

#define GAS __attribute__((address_space(1)))
#define LAS __attribute__((address_space(3)))
typedef unsigned short bf16;
typedef unsigned v4u __attribute__((ext_vector_type(4)));
typedef unsigned v2u __attribute__((ext_vector_type(2)));
typedef float f32x4 __attribute__((ext_vector_type(4)));
typedef GAS unsigned gu32;
#define RLX_AGENT __ATOMIC_RELAXED, __HIP_MEMORY_SCOPE_AGENT

__device__ __forceinline__ unsigned f2bf(float f) { unsigned u = __builtin_bit_cast(unsigned, f); return (u + 0x7fffu + ((u >> 16) & 1u)) >> 16; }
__device__ __forceinline__ unsigned pk2(float lo, float hi) { return f2bf(lo) | (f2bf(hi) << 16); }
__device__ __forceinline__ float bflo(unsigned w) { return __uint_as_float(w << 16); }
__device__ __forceinline__ float bfhi(unsigned w) { return __uint_as_float(w & 0xffff0000u); }
__device__ __forceinline__ float bf2f(bf16 v) { return __uint_as_float((unsigned)v << 16); }
__device__ __forceinline__ float wave_sum(float v) {
#pragma unroll
    for (int o = 1; o < 64; o <<= 1) v += __shfl_xor(v, o);
    return v;
}

__device__ __forceinline__ int lane_id() { int l; asm volatile("v_mbcnt_lo_u32_b32 %0, -1, 0\n\tv_mbcnt_hi_u32_b32 %0, -1, %0" : "=v"(l)); return l; }
#define XB_TMO      128
#define XB_XCNT(j)  (256  + 64 * (j))
#define XB_XSUB(j)  (1280 + 64 * (j))
#define XB_XGEN(j)  (2304 + 64 * (j))
#define XB_TOP      3328
#define XB_TOPGEN   3392
#define XCD_BAR_WORDS 3456
#define XB_SPIN_CAP (1u << 18)
__device__ __forceinline__ unsigned xb_ld(unsigned* p)              { return __hip_atomic_load(p, __ATOMIC_RELAXED, __HIP_MEMORY_SCOPE_AGENT); }
__device__ __forceinline__ unsigned xb_add(unsigned* p, unsigned v) { return __hip_atomic_fetch_add(p, v, __ATOMIC_RELAXED, __HIP_MEMORY_SCOPE_AGENT); }
__device__ __forceinline__ unsigned xb_xcc_id() { return (unsigned)__builtin_amdgcn_s_getreg((3 << 11) | 20) & 0xFu; }
#define XB_SPIN(cond, bar) do { unsigned _sp = 0; while (cond) { __builtin_amdgcn_s_sleep(1); \
    if ((++_sp & 255u) == 0u) { if (xb_ld(&(bar)[XB_TMO])) break; if (_sp > XB_SPIN_CAP) { atomicAdd(&(bar)[XB_TMO], 1u); break; } } } } while (0)
struct XcdBarrier { unsigned* bar; unsigned x; volatile LAS unsigned* st; };
__device__ __forceinline__ XcdBarrier xcd_barrier_post(unsigned* bar, volatile LAS unsigned* st) {
    XcdBarrier b; b.bar = bar; b.x = xb_xcc_id(); b.st = st;
    if (threadIdx.x == 0) (void)xb_add(&bar[XB_XCNT(b.x)], 1u);
    return b;
}
__device__ __forceinline__ void xcd_barrier_complete(unsigned* bar, unsigned x, unsigned& nloc, unsigned& nx) {
    const unsigned G = gridDim.x * gridDim.y * gridDim.z;
    unsigned sum, cnt, mine, sp = 0u;
    for (;;) {
        sum = 0u; cnt = 0u; mine = 0u;
#pragma unroll
        for (unsigned j = 0; j < 16; ++j) { const unsigned c = xb_ld(&bar[XB_XCNT(j)]); sum += c; cnt += (c > 0u) ? 1u : 0u; mine = (j == x) ? c : mine; }
        if (sum == G) break;
        __builtin_amdgcn_s_sleep(1);
        if ((++sp & 255u) == 0u) { if (xb_ld(&bar[XB_TMO])) break; if (sp > XB_SPIN_CAP) { atomicAdd(&bar[XB_TMO], 1u); break; } }
    }
    nloc = mine > 0u ? mine : 1u; nx = cnt > 0u ? cnt : 1u;
}
__device__ __forceinline__ void xcd_barrier(const XcdBarrier& b, int wave) {
    asm volatile("s_waitcnt vmcnt(0)" ::: "memory");
    __syncthreads();
    if (wave == 0 && lane_id() == 0) {
        unsigned* bar = b.bar;
        __builtin_amdgcn_s_waitcnt(0);
        unsigned nloc = b.st[0], nx = b.st[1];
        if (nloc == 0u) { xcd_barrier_complete(bar, b.x, nloc, nx); b.st[0] = nloc; b.st[1] = nx; }
        const unsigned old = xb_add(&bar[XB_XSUB(b.x)], 1u);
        const unsigned gen = old / nloc;
        if (old + 1u == (gen + 1u) * nloc) {
            __builtin_amdgcn_fence(__ATOMIC_RELEASE, "agent");
            asm volatile("s_waitcnt vmcnt(0)" ::: "memory");
            const unsigned og = xb_add(&bar[XB_TOP], 1u);
            const unsigned tg = og / nx;
            if (og + 1u == (tg + 1u) * nx) xb_add(&bar[XB_TOPGEN], 1u);
            else XB_SPIN(xb_ld(&bar[XB_TOPGEN]) == tg, bar);
            __builtin_amdgcn_fence(__ATOMIC_ACQUIRE, "agent");
            xb_add(&bar[XB_XGEN(b.x)], 1u);
            asm volatile("s_waitcnt vmcnt(0)" ::: "memory");
        } else {
            XB_SPIN(xb_ld(&bar[XB_XGEN(b.x)]) == gen, bar);
            __builtin_amdgcn_fence(__ATOMIC_ACQUIRE, "agent");
            asm volatile("s_waitcnt vmcnt(0)" ::: "memory");
        }
    }
    __syncthreads();
}

struct Frame {
    LAS unsigned char* lds;
    volatile LAS unsigned* MISC;
    gu32* ctl;
    float *PA, *PO;
    int tid, lane, wave, vcu, G; unsigned char* ws;
    const float *x, *p; const int* pos;
    const float *w_in, *g_attn, *g_cq, *w_uq, *g_ckv, *w_ukv, *g_out_mla, *g_out_sb, *w_o, *g_moe, *w_router, *b_router, *w_gu, *b_gu, *w_dn, *b_dn, *g_ple, *w_ple_gate, *w_ple_proj, *g_final;
    float* out;
    bf16 *XN, *Y1, *Q, *KN, *VM, *O, *PBF, *PROJ, *XG, *ACT, *Yb;
    float *H1, *COS, *SIN;
    int *topk_e, *lpos, *slot; float* gate;
};

__device__ __forceinline__ unsigned long long lds_arg(Frame& F, int i) {
    const LAS unsigned* ap = (const LAS unsigned*)(F.lds + L_ARGS) + 2 * i;
    const unsigned lo = __builtin_amdgcn_readfirstlane(ap[0]), hi = __builtin_amdgcn_readfirstlane(ap[1]);
    return ((unsigned long long)hi << 32) | lo;
}
__device__ __forceinline__ void frame_refresh(Frame& F) {
    asm volatile("" ::: "memory");
    F.lane = lane_id(); F.tid = F.wave * 64 + F.lane;
    F.x = (const float*)lds_arg(F, 0); F.p = (const float*)lds_arg(F, 1); F.pos = (const int*)lds_arg(F, 2);
    F.w_in = (const float*)lds_arg(F, 3); F.g_attn = (const float*)lds_arg(F, 4); F.g_cq = (const float*)lds_arg(F, 5); F.w_uq = (const float*)lds_arg(F, 6); F.g_ckv = (const float*)lds_arg(F, 7);
    F.w_ukv = (const float*)lds_arg(F, 8); F.g_out_mla = (const float*)lds_arg(F, 9); F.g_out_sb = (const float*)lds_arg(F, 10); F.w_o = (const float*)lds_arg(F, 11); F.g_moe = (const float*)lds_arg(F, 12);
    F.w_router = (const float*)lds_arg(F, 13); F.b_router = (const float*)lds_arg(F, 14); F.w_gu = (const float*)lds_arg(F, 15); F.b_gu = (const float*)lds_arg(F, 16); F.w_dn = (const float*)lds_arg(F, 17);
    F.b_dn = (const float*)lds_arg(F, 18); F.g_ple = (const float*)lds_arg(F, 19); F.w_ple_gate = (const float*)lds_arg(F, 20); F.w_ple_proj = (const float*)lds_arg(F, 21); F.g_final = (const float*)lds_arg(F, 22);
    F.out = (float*)lds_arg(F, 23);
    unsigned char* ws = (unsigned char*)lds_arg(F, 24); F.ws = ws;
    F.ctl = (gu32*)(ws + WS_CTL); F.PA = (float*)(ws + WS_PARTA); F.PO = (float*)(ws + WS_PARTO);
    F.XN = (bf16*)(ws + WS_XN); F.Y1 = (bf16*)(ws + WS_Y1); F.Q = (bf16*)(ws + WS_Q); F.KN = (bf16*)(ws + WS_KN); F.VM = (bf16*)(ws + WS_VM); F.O = (bf16*)(ws + WS_O);
    F.PBF = (bf16*)(ws + WS_PBF); F.PROJ = (bf16*)(ws + WS_PROJ); F.XG = (bf16*)(ws + WS_XG); F.ACT = (bf16*)(ws + WS_ACT); F.Yb = (bf16*)(ws + WS_XG);
    F.H1 = (float*)(ws + WS_H1); F.COS = (float*)(ws + WS_CS); F.SIN = (float*)(ws + WS_CS + MiB);
    F.topk_e = (int*)(ws + WS_ROUTE); F.gate = (float*)(ws + WS_ROUTE + 256 * 1024); F.lpos = (int*)(ws + WS_ROUTE + 512 * 1024); F.slot = (int*)(ws + WS_ROUTE + 768 * 1024);
}
__device__ __forceinline__ void p0_prologue(Frame& F) {
    const int gw = F.vcu * NWAVES + F.wave, NGW = F.G * NWAVES;
#if !OPT_ROW
    for (int m = gw; m < T; m += NGW) {
        const GAS f32x4* xr = (const GAS f32x4*)(F.x + (size_t)m * D) + F.lane;
        f32x4 v[4]; float s = 0.f;
#pragma unroll
        for (int j = 0; j < 4; ++j) { v[j] = xr[64 * j]; s += (v[j].x * v[j].x + v[j].y * v[j].y) + (v[j].z * v[j].z + v[j].w * v[j].w); }
        const float r = 1.0f / sqrtf(wave_sum(s) * (1.f / D) + EPS);
        GAS v2u* o8 = (GAS v2u*)(F.XN + (size_t)m * D) + F.lane;
#pragma unroll
        for (int j = 0; j < 4; ++j) { v2u w; w.x = pk2(v[j].x * r, v[j].y * r); w.y = pk2(v[j].z * r, v[j].w * r); o8[64 * j] = w; }
    }
#endif
    const int gt = blockIdx.x * NTHR + F.tid, NT = F.G * NTHR;
    for (int i = gt; i < T * PLE / 4; i += NT) { const f32x4 v = ((const GAS f32x4*)F.p)[i]; v2u w; w.x = pk2(v.x, v.y); w.y = pk2(v.z, v.w); ((GAS v2u*)F.PBF)[i] = w; }
    for (int i = gt; i < T * 16; i += NT) {
        const int m = i >> 4, f = i & 15;
        const float invf = exp2f(-(float)f * (13.287712379549449f / 16.0f));
        const float ang = (float)F.pos[m] * invf;
        double t = (double)ang * 0.15915494309189535; t -= __builtin_rint(t);
        const float fr = (float)t;
        F.COS[i] = __builtin_amdgcn_cosf(fr); F.SIN[i] = __builtin_amdgcn_sinf(fr);
    }
}

__device__ __forceinline__ float sum8(const float* p) { const f32x4 a = *(const GAS f32x4*)p, b = *(const GAS f32x4*)(p + 4); return ((a.x + a.y) + (a.z + a.w)) + ((b.x + b.y) + (b.z + b.w)); }
__device__ __forceinline__ void naive_rowssq(Frame& F) {
    const int gw = F.vcu * NWAVES + F.wave, NGW = F.G * NWAVES;
    for (int m = gw; m < T; m += NGW) {
        float sq = 0.f, skv = 0.f;
        for (int c = F.lane; c < C_KR; c += 64) { const float v = bf2f(F.Y1[(size_t)m * NINP + c]); if (c < C_CKV) sq += v * v; else skv += v * v; }
        sq = wave_sum(sq); skv = wave_sum(skv);
        if (F.lane < 16) F.PA[(size_t)m * 16 + F.lane] = (F.lane == 0) ? sq : (F.lane == 8) ? skv : 0.f;
    }
}
template <class Epi>
__device__ __forceinline__ void naive_gemm(Frame& F, const bf16* A, int lda, int M, const Epi& E) {
    const long total = (long)(M / 8) * E.nv;
    const long gt = (long)blockIdx.x * NTHR + F.tid, NT = (long)F.G * NTHR;
    for (long it = gt; it < total; it += NT) {
        const int j = (int)(it % E.nv), m0 = (int)(it / E.nv) * 8;
        const float* W; int ldw; const float *gk0, *gk1; int c0, c1, ka0, kb0, ka1, kb1;
        if (!E.setup(F, m0, j, W, ldw, gk0, gk1, c0, c1, ka0, kb0, ka1, kb1)) continue;
        float a0[8], a1[8];
#pragma unroll
        for (int r = 0; r < 8; ++r) { a0[r] = 0.f; a1[r] = 0.f; }
        const bf16* Ar = A + (size_t)m0 * lda;
        for (int k = ka0; k < kb0; k += 8) {
            v4u av[8];
#pragma unroll
            for (int r = 0; r < 8; ++r) av[r] = *(const GAS v4u*)(Ar + (size_t)r * lda + k);
#pragma unroll
            for (int kk = 0; kk < 8; ++kk) {
                const float w = W[(size_t)(k + kk) * ldw + c0] * (gk0 ? gk0[k + kk] : 1.f);
#pragma unroll
                for (int r = 0; r < 8; ++r) { const unsigned u = av[r][kk >> 1]; a0[r] += ((kk & 1) ? bfhi(u) : bflo(u)) * w; }
            }
        }
        for (int k = ka1; k < kb1; k += 8) {
            v4u av[8];
#pragma unroll
            for (int r = 0; r < 8; ++r) av[r] = *(const GAS v4u*)(Ar + (size_t)r * lda + k);
#pragma unroll
            for (int kk = 0; kk < 8; ++kk) {
                const float w = W[(size_t)(k + kk) * ldw + c1] * (gk1 ? gk1[k + kk] : 1.f);
#pragma unroll
                for (int r = 0; r < 8; ++r) { const unsigned u = av[r][kk >> 1]; a1[r] += ((kk & 1) ? bfhi(u) : bflo(u)) * w; }
            }
        }
        E.store(F, m0, j, a0, a1);
    }
}

__device__ __forceinline__ int expert_of_tile(Frame& F, int tile) {
    const volatile LAS int* ts = (const volatile LAS int*)(F.lds + L_TSTART);
    int e = -1;
    for (int i = 0; i < NE; ++i) if (tile >= ts[i] && tile < ts[i + 1]) e = i;
    return e;
}

struct NE_InProj {
    int nv;
    __device__ __forceinline__ bool setup(Frame& Fr, int m0, int j, const float*& W, int& ldw, const float*& gk0, const float*& gk1, int& c0, int& c1, int& ka0, int& kb0, int& ka1, int& kb1) const {
        if (j >= C_KR + 16 && j < C_QS) return false;
        W = Fr.w_in; ldw = NIN; gk0 = Fr.g_attn; gk1 = Fr.g_attn; c0 = j; c1 = j; ka0 = 0; kb0 = D; ka1 = 0; kb1 = 0;
        if (j >= C_KR && j < C_KR + 16) { c1 = j + 16; kb1 = D; }
        return true;
    }
    __device__ __forceinline__ void store(Frame& Fr, int m0, int j, const float* a0, const float* a1) const {
#pragma unroll
        for (int r = 0; r < 8; ++r) {
            const int m = m0 + r; bf16* y = Fr.Y1 + (size_t)m * NINP;
            if (j < C_KR) y[j] = (bf16)f2bf(a0[r]);
            else if (j < C_KR + 16) { const int i = j - C_KR; const float c = Fr.COS[m * 16 + i], s = Fr.SIN[m * 16 + i];
                y[C_KR + 2 * i] = (bf16)f2bf(a0[r] * c - a1[r] * s); y[C_KR + 2 * i + 1] = (bf16)f2bf(a1[r] * c + a0[r] * s); }
            else if (j < C_KS) y[j] = (bf16)f2bf(a0[r] * QS_SCALE);
            else y[j] = (bf16)f2bf(a0[r]);
        }
    }
};
struct NE_Q {
    int nv;
    __device__ __forceinline__ bool setup(Frame& Fr, int m0, int j, const float*& W, int& ldw, const float*& gk0, const float*& gk1, int& c0, int& c1, int& ka0, int& kb0, int& ka1, int& kb1) const {
        const int w = j % QKD; if (w >= NOPE + 16) return false;
        W = Fr.w_uq; ldw = HM * QKD; gk0 = Fr.g_cq; gk1 = Fr.g_cq; c0 = j; c1 = j; ka0 = 0; kb0 = QLR; ka1 = 0; kb1 = 0;
        if (w >= NOPE) { c1 = j + 16; kb1 = QLR; }
        return true;
    }
    __device__ __forceinline__ void store(Frame& Fr, int m0, int j, const float* a0, const float* a1) const {
        const int h = j / QKD, w = j % QKD;
#pragma unroll
        for (int r = 0; r < 8; ++r) {
            const int m = m0 + r; bf16* q = Fr.Q + (size_t)m * (HM * QKD) + h * QKD;
            const float rinv = 1.0f / sqrtf(sum8(Fr.PA + (size_t)m * 16) * (1.f / QLR) + EPS) * Q_SCALE;
            if (w < NOPE) q[w] = (bf16)f2bf(a0[r] * rinv);
            else { const int i = w - NOPE; const float c = Fr.COS[m * 16 + i], s = Fr.SIN[m * 16 + i]; const float x1 = a0[r] * rinv, x2 = a1[r] * rinv;
                q[NOPE + 2 * i] = (bf16)f2bf(x1 * c - x2 * s); q[NOPE + 2 * i + 1] = (bf16)f2bf(x2 * c + x1 * s); }
        }
    }
};
struct NE_KV {
    int nv;
    __device__ __forceinline__ bool setup(Frame& Fr, int m0, int j, const float*& W, int& ldw, const float*& gk0, const float*& gk1, int& c0, int& c1, int& ka0, int& kb0, int& ka1, int& kb1) const {
        W = Fr.w_ukv; ldw = HM * (NOPE + VDIM); gk0 = Fr.g_ckv; gk1 = nullptr; c0 = j; c1 = j; ka0 = 0; kb0 = KVLR; ka1 = 0; kb1 = 0; return true;
    }
    __device__ __forceinline__ void store(Frame& Fr, int m0, int j, const float* a0, const float* a1) const {
        const int h = j / 128, w = j % 128;
#pragma unroll
        for (int r = 0; r < 8; ++r) {
            const int m = m0 + r;
            const float rinv = 1.0f / sqrtf(sum8(Fr.PA + (size_t)m * 16 + 8) * (1.f / KVLR) + EPS);
            if (w < NOPE) Fr.KN[(size_t)m * 512 + h * 64 + w] = (bf16)f2bf(a0[r] * rinv);
            else Fr.VM[(size_t)m * 512 + h * 64 + (w - NOPE)] = (bf16)f2bf(a0[r] * rinv);
        }
    }
};
struct NE_Wo {
    int nv;
    __device__ __forceinline__ bool setup(Frame& Fr, int m0, int j, const float*& W, int& ldw, const float*& gk0, const float*& gk1, int& c0, int& c1, int& ka0, int& kb0, int& ka1, int& kb1) const {
        W = Fr.w_o; ldw = D; gk0 = Fr.g_out_mla; gk1 = Fr.g_out_sb - 512; c0 = j; c1 = j; ka0 = 0; kb0 = 512; ka1 = 512; kb1 = 1024; return true;
    }
    __device__ __forceinline__ void store(Frame& Fr, int m0, int j, const float* a0, const float* a1) const {
#pragma unroll
        for (int r = 0; r < 8; ++r) {
            const int m = m0 + r;
            const float rm = 1.0f / sqrtf(sum8(Fr.PO + (size_t)m * 16) * (1.f / 512) + EPS), rs = 1.0f / sqrtf(sum8(Fr.PO + (size_t)m * 16 + 8) * (1.f / 512) + EPS);
            Fr.H1[(size_t)m * D + j] = Fr.x[(size_t)m * D + j] + a0[r] * rm + a1[r] * rs;
        }
    }
};
struct NE_Gu {
    int nv;
    __device__ __forceinline__ bool setup(Frame& Fr, int m0, int j, const float*& W, int& ldw, const float*& gk0, const float*& gk1, int& c0, int& c1, int& ka0, int& kb0, int& ka1, int& kb1) const {
        const int e = expert_of_tile(Fr, m0 >> 8); if (e < 0) return false;
        W = Fr.w_gu + (size_t)e * D * 2 * DFF; ldw = 2 * DFF; gk0 = Fr.g_moe; gk1 = Fr.g_moe; c0 = j; c1 = DFF + j; ka0 = 0; kb0 = D; ka1 = 0; kb1 = D; return true;
    }
    __device__ __forceinline__ void store(Frame& Fr, int m0, int j, const float* a0, const float* a1) const {
        const int e = expert_of_tile(Fr, m0 >> 8);
        const float bg = Fr.b_gu[e * 2 * DFF + j], bl = Fr.b_gu[e * 2 * DFF + DFF + j];
#pragma unroll
        for (int r = 0; r < 8; ++r) {
            float g = fminf(a0[r] + bg, 7.0f), l = fminf(fmaxf(a1[r] + bl, -7.0f), 7.0f);
            const float act = g * (1.0f / (1.0f + __expf(-1.702f * g))) * (l + 1.0f);
            Fr.ACT[(size_t)(m0 + r) * DFF + j] = (bf16)f2bf(act);
        }
    }
};
struct NE_Dn {
    int nv;
    __device__ __forceinline__ bool setup(Frame& Fr, int m0, int j, const float*& W, int& ldw, const float*& gk0, const float*& gk1, int& c0, int& c1, int& ka0, int& kb0, int& ka1, int& kb1) const {
        const int e = expert_of_tile(Fr, m0 >> 8); if (e < 0) return false;
        W = Fr.w_dn + (size_t)e * DFF * D; ldw = D; gk0 = nullptr; gk1 = nullptr; c0 = j; c1 = j; ka0 = 0; kb0 = DFF; ka1 = 0; kb1 = 0; return true;
    }
    __device__ __forceinline__ void store(Frame& Fr, int m0, int j, const float* a0, const float* a1) const {
        const int e = expert_of_tile(Fr, m0 >> 8);
        const float b = Fr.b_dn[e * D + j];
#pragma unroll
        for (int r = 0; r < 8; ++r) Fr.Yb[(size_t)(m0 + r) * D + j] = (bf16)f2bf(a0[r] + b);
    }
};
struct NE_Proj {
    int nv;
    __device__ __forceinline__ bool setup(Frame& Fr, int m0, int j, const float*& W, int& ldw, const float*& gk0, const float*& gk1, int& c0, int& c1, int& ka0, int& kb0, int& ka1, int& kb1) const {
        W = Fr.w_ple_proj; ldw = D; gk0 = nullptr; gk1 = nullptr; c0 = j; c1 = j; ka0 = 0; kb0 = PLE; ka1 = 0; kb1 = 0; return true;
    }
    __device__ __forceinline__ void store(Frame& Fr, int m0, int j, const float* a0, const float* a1) const {
#pragma unroll
        for (int r = 0; r < 8; ++r) Fr.PROJ[(size_t)(m0 + r) * D + j] = (bf16)f2bf(a0[r]);
    }
};
struct NE_Gate {
    int nv;
    __device__ __forceinline__ bool setup(Frame& Fr, int m0, int j, const float*& W, int& ldw, const float*& gk0, const float*& gk1, int& c0, int& c1, int& ka0, int& kb0, int& ka1, int& kb1) const {
        W = Fr.w_ple_gate; ldw = D; gk0 = Fr.g_ple; gk1 = nullptr; c0 = j; c1 = j; ka0 = 0; kb0 = D; ka1 = 0; kb1 = 0; return true;
    }
    __device__ __forceinline__ void store(Frame& Fr, int m0, int j, const float* a0, const float* a1) const {
#pragma unroll
        for (int r = 0; r < 8; ++r) {
            const int m = m0 + r;
            const float h3 = Fr.H1[(size_t)m * D + j] + (1.0f / (1.0f + __expf(-a0[r]))) * bf2f(Fr.PROJ[(size_t)m * D + j]);
            Fr.out[(size_t)m * D + j] = h3;
        }
    }
};

__device__ __forceinline__ void naive_attention(Frame& F) {
    const long gt = (long)blockIdx.x * NTHR + F.tid, NT = (long)F.G * NTHR;
    const long total = 2L * T * 8;
    for (long it = gt; it < total; it += NT) {
        const int tl = (int)(it & 63); long r = it >> 6;
        const int h = (int)(r & 7); r >>= 3; const int grp = (int)(r & 1); r >>= 1; const int b = (int)(r & 3); r >>= 2; const int tc = (int)r;
        const int t = tc * 64 + tl; const int m = b * SEQ + t;
        float o[64];
#pragma unroll
        for (int d = 0; d < 64; ++d) o[d] = 0.f;
        if (grp == 0) {
            unsigned q[48];
            const GAS v4u* qp = (const GAS v4u*)(F.Q + (size_t)m * (HM * QKD) + h * QKD);
#pragma unroll
            for (int c = 0; c < 12; ++c) { const v4u v = qp[c]; q[4 * c] = v.x; q[4 * c + 1] = v.y; q[4 * c + 2] = v.z; q[4 * c + 3] = v.w; }
            float mx = -1e30f, l = 0.f;
            for (int s = 0; s <= t; ++s) {
                const int ms = b * SEQ + s;
                const GAS v4u* kp = (const GAS v4u*)(F.KN + (size_t)ms * 512 + h * 64);
                const GAS v4u* kr = (const GAS v4u*)(F.Y1 + (size_t)ms * NINP + C_KR);
                float sc = 0.f;
#pragma unroll
                for (int c = 0; c < 12; ++c) { const v4u kv = (c < 8) ? kp[c] : kr[c - 8];
#pragma unroll
                    for (int i = 0; i < 4; ++i) sc += bflo(q[4 * c + i]) * bflo(kv[i]) + bfhi(q[4 * c + i]) * bfhi(kv[i]); }
                const float mn = fmaxf(mx, sc), al = exp2f(mx - mn), pp = exp2f(sc - mn);
                l = l * al + pp; mx = mn;
                const GAS v4u* vp = (const GAS v4u*)(F.VM + (size_t)ms * 512 + h * 64);
#pragma unroll
                for (int c = 0; c < 8; ++c) { const v4u vv = vp[c];
#pragma unroll
                    for (int i = 0; i < 4; ++i) { o[8 * c + 2 * i] = o[8 * c + 2 * i] * al + pp * bflo(vv[i]); o[8 * c + 2 * i + 1] = o[8 * c + 2 * i + 1] * al + pp * bfhi(vv[i]); } }
            }
            const float rl = 1.0f / l;
#pragma unroll
            for (int d = 0; d < 64; ++d) o[d] *= rl;
        } else {
            unsigned q[32];
            const GAS v4u* qp = (const GAS v4u*)(F.Y1 + (size_t)m * NINP + C_QS + h * 64);
#pragma unroll
            for (int c = 0; c < 8; ++c) { const v4u v = qp[c]; q[4 * c] = v.x; q[4 * c + 1] = v.y; q[4 * c + 2] = v.z; q[4 * c + 3] = v.w; }
            float run = 0.f;
            for (int s = t - 1; s >= 0; --s) {
                if (run < SB_DONE) break;
                const int ms = b * SEQ + s;
                const GAS v4u* kp = (const GAS v4u*)(F.Y1 + (size_t)ms * NINP + C_KS + h * 64);
                float z = 0.f;
#pragma unroll
                for (int c = 0; c < 8; ++c) { const v4u kv = kp[c];
#pragma unroll
                    for (int i = 0; i < 4; ++i) z += bflo(q[4 * c + i]) * bflo(kv[i]) + bfhi(q[4 * c + i]) * bfhi(kv[i]); }
                const float sp = fmaxf(z, 0.f) + log2f(1.0f + exp2f(-fabsf(z)));
                const float a = exp2f(z - sp + run);
                run -= sp;
                const GAS v4u* vp = (const GAS v4u*)(F.Y1 + (size_t)ms * NINP + C_VS + h * 64);
#pragma unroll
                for (int c = 0; c < 8; ++c) { const v4u vv = vp[c];
#pragma unroll
                    for (int i = 0; i < 4; ++i) { o[8 * c + 2 * i] += a * bflo(vv[i]); o[8 * c + 2 * i + 1] += a * bfhi(vv[i]); } }
            }
        }
        float ss = 0.f;
        GAS v4u* op = (GAS v4u*)(F.O + (size_t)m * D + grp * 512 + h * 64);
#pragma unroll
        for (int c = 0; c < 8; ++c) { v4u w;
#pragma unroll
            for (int i = 0; i < 4; ++i) { w[i] = pk2(o[8 * c + 2 * i], o[8 * c + 2 * i + 1]); ss += o[8 * c + 2 * i] * o[8 * c + 2 * i] + o[8 * c + 2 * i + 1] * o[8 * c + 2 * i + 1]; }
            op[c] = w; }
        F.PO[(size_t)m * 16 + grp * 8 + h] = ss;
    }
}

__device__ __forceinline__ void p5a_route(Frame& F) {
    LAS float* WR = (LAS float*)(F.lds + RING_OFF);
    for (int i = F.tid; i < D * NE / 4; i += NTHR) {
        const f32x4 v = ((const GAS f32x4*)F.w_router)[i]; const int k = (4 * i) / NE, e0 = (4 * i) % NE; const float g = F.g_moe[k];
        WR[(e0 + 0) * D + k] = v.x * g; WR[(e0 + 1) * D + k] = v.y * g; WR[(e0 + 2) * D + k] = v.z * g; WR[(e0 + 3) * D + k] = v.w * g;
    }
    volatile LAS unsigned* lcnt = (volatile LAS unsigned*)(F.lds + L_LCNT);
    LAS unsigned* rscr = (LAS unsigned*)(F.lds + L_RSCR) + F.wave * 64;
    if (F.tid < 64) lcnt[F.tid] = 0u;
    __syncthreads();
    const int gw = F.vcu * NWAVES + F.wave, NGW = F.G * NWAVES;
    const int lane = F.lane;
    const int myexp = ((lane & 1) << 4) | ((lane & 2) << 2) | (lane & 4) | ((lane & 8) >> 2) | ((lane & 16) >> 4);
    const float mybias = F.b_router[myexp];
    int ri = 0;
    for (int m = gw; m < T; m += NGW, ++ri) {
        const GAS f32x4* xr = (const GAS f32x4*)(F.H1 + (size_t)m * D) + lane;
        f32x4 v[4]; float s = 0.f;
#pragma unroll
        for (int j = 0; j < 4; ++j) { v[j] = xr[64 * j]; s += (v[j].x * v[j].x + v[j].y * v[j].y) + (v[j].z * v[j].z + v[j].w * v[j].w); }
        const float r = 1.0f / sqrtf(wave_sum(s) * (1.f / D) + EPS);
        GAS v2u* o8 = (GAS v2u*)(F.XN + (size_t)m * D) + lane;
#pragma unroll
        for (int j = 0; j < 4; ++j) { v[j] = v[j] * r; v2u w; w.x = pk2(v[j].x, v[j].y); w.y = pk2(v[j].z, v[j].w); o8[64 * j] = w; }
        float a[32];
#pragma unroll
        for (int e = 0; e < 32; ++e) {
            float acc = 0.f;
#pragma unroll
            for (int j = 0; j < 4; ++j) { const f32x4 w = *(const LAS f32x4*)(WR + e * D + 256 * j + 4 * lane); acc += (v[j].x * w.x + v[j].y * w.y) + (v[j].z * w.z + v[j].w * w.w); }
            a[e] = acc;
            if ((e & 1) == 1) __builtin_amdgcn_sched_barrier(0);
        }
#pragma unroll
        for (int st = 0; st < 5; ++st) {
            const int hh = 16 >> st; const bool up = (lane >> st) & 1;
#pragma unroll
            for (int i = 0; i < hh; ++i) { const float send = up ? a[i] : a[hh + i]; const float recv = __shfl_xor(send, 1 << st); a[i] = (up ? a[hh + i] : a[i]) + recv; }
        }
        float val = a[0] + __shfl_xor(a[0], 32) + mybias;
        int tv_i[4]; float tv_v[4];
#pragma unroll
        for (int k = 0; k < 4; ++k) {
            float bv = val; int bi = myexp;
#pragma unroll
            for (int off = 1; off < 32; off <<= 1) { const float ov = __shfl_xor(bv, off); const int oi = __shfl_xor(bi, off); if (ov > bv || (ov == bv && oi < bi)) { bv = ov; bi = oi; } }
            tv_v[k] = bv; tv_i[k] = bi; if (myexp == bi) val = -INFINITY;
        }
        float g[4], gs = 0.f;
#pragma unroll
        for (int k = 0; k < 4; ++k) { g[k] = __expf(tv_v[k] - tv_v[0]); gs += g[k]; }
        const float rg = 1.0f / gs;
        if (lane == 0) {
#pragma unroll
            for (int k = 0; k < 4; ++k) {
                const unsigned pos = __hip_atomic_fetch_add((LAS unsigned*)(F.lds + L_LCNT) + tv_i[k], 1u, __ATOMIC_RELAXED, __HIP_MEMORY_SCOPE_WORKGROUP);
                F.topk_e[m * 4 + k] = tv_i[k]; F.gate[m * 4 + k] = g[k] * rg;
                if (ri < 8) { rscr[ri * 8 + k] = (unsigned)tv_i[k]; rscr[ri * 8 + 4 + k] = pos; }
            }
        }
    }
    __syncthreads();
    if (F.tid < 32) lcnt[32 + F.tid] = __hip_atomic_fetch_add((unsigned*)(F.ctl + CW_CNT) + F.tid, lcnt[F.tid], RLX_AGENT);
    __syncthreads();
    ri = 0;
    for (int m = gw; m < T; m += NGW, ++ri) if (lane < 4 && ri < 8) F.lpos[m * 4 + lane] = (int)(rscr[ri * 8 + 4 + lane] + lcnt[32 + rscr[ri * 8 + lane]]);
}
__device__ __forceinline__ void build_tstart(Frame& F) {
    volatile LAS int* ts = (volatile LAS int*)(F.lds + L_TSTART);
    if (F.tid == 0) { int acc = 0; for (int e = 0; e < NE; ++e) { ts[e] = acc; const unsigned c = __hip_atomic_load((unsigned*)(F.ctl + CW_CNT) + e, RLX_AGENT); acc += (int)((c + 255u) >> 8); } ts[NE] = acc; ts[40] = acc; }
    __syncthreads();
}
__device__ __forceinline__ void p5b_gather(Frame& F) {
    build_tstart(F);
    const volatile LAS int* ts = (const volatile LAS int*)(F.lds + L_TSTART);
    const int gw = F.vcu * NWAVES + F.wave, NGW = F.G * NWAVES;
    for (int m = gw; m < T; m += NGW) {
        const GAS v4u* src = (const GAS v4u*)(F.XN + (size_t)m * D) + F.lane;
        const v4u a = src[0], b = src[64];
#pragma unroll
        for (int k = 0; k < 4; ++k) {
            const int e = F.topk_e[m * 4 + k]; const int sl = ts[e] * 256 + F.lpos[m * 4 + k];
            if (F.lane == 0) F.slot[m * 4 + k] = sl;
            GAS v4u* dst = (GAS v4u*)(F.XG + (size_t)sl * D) + F.lane; dst[0] = a; dst[64] = b;
        }
    }
}
__device__ __forceinline__ void p8_combine(Frame& F) {
    const int gw = F.vcu * NWAVES + F.wave, NGW = F.G * NWAVES; const int lane = F.lane;
    for (int m = gw; m < T; m += NGW) {
        int sl[4]; float g[4];
#pragma unroll
        for (int k = 0; k < 4; ++k) { sl[k] = F.slot[m * 4 + k]; g[k] = F.gate[m * 4 + k]; }
        f32x4 h[2][2]; float s = 0.f;
#pragma unroll
        for (int j = 0; j < 2; ++j) {
            GAS f32x4* hp = (GAS f32x4*)(F.H1 + (size_t)m * D + 512 * j + 8 * lane);
            h[j][0] = hp[0]; h[j][1] = hp[1];
#pragma unroll
            for (int k = 0; k < 4; ++k) {
                const v4u y = *(const GAS v4u*)(F.Yb + (size_t)sl[k] * D + 512 * j + 8 * lane);
                h[j][0].x += g[k] * bflo(y.x); h[j][0].y += g[k] * bfhi(y.x); h[j][0].z += g[k] * bflo(y.y); h[j][0].w += g[k] * bfhi(y.y);
                h[j][1].x += g[k] * bflo(y.z); h[j][1].y += g[k] * bfhi(y.z); h[j][1].z += g[k] * bflo(y.w); h[j][1].w += g[k] * bfhi(y.w);
            }
            hp[0] = h[j][0]; hp[1] = h[j][1];
#pragma unroll
            for (int i = 0; i < 2; ++i) s += (h[j][i].x * h[j][i].x + h[j][i].y * h[j][i].y) + (h[j][i].z * h[j][i].z + h[j][i].w * h[j][i].w);
        }
        const float r = 1.0f / sqrtf(wave_sum(s) * (1.f / D) + EPS);
#pragma unroll
        for (int j = 0; j < 2; ++j) { v4u w; w.x = pk2(h[j][0].x * r, h[j][0].y * r); w.y = pk2(h[j][0].z * r, h[j][0].w * r); w.z = pk2(h[j][1].x * r, h[j][1].y * r); w.w = pk2(h[j][1].z * r, h[j][1].w * r);
            *(GAS v4u*)(F.XN + (size_t)m * D + 512 * j + 8 * lane) = w; }
    }
}
__device__ __forceinline__ void p10_final(Frame& F) {
    const int gw = F.vcu * NWAVES + F.wave, NGW = F.G * NWAVES; const int lane = F.lane;
    for (int m = gw; m < T; m += NGW) {
        GAS f32x4* op = (GAS f32x4*)(F.out + (size_t)m * D) + lane;
        f32x4 v[4]; float s = 0.f;
#pragma unroll
        for (int j = 0; j < 4; ++j) { v[j] = op[64 * j]; s += (v[j].x * v[j].x + v[j].y * v[j].y) + (v[j].z * v[j].z + v[j].w * v[j].w); }
        const float r = 1.0f / sqrtf(wave_sum(s) * (1.f / D) + EPS);
#pragma unroll
        for (int j = 0; j < 4; ++j) { const f32x4 g = ((const GAS f32x4*)F.g_final)[64 * j + lane]; op[64 * j] = v[j] * r * g; }
    }
}

constexpr size_t WS_WRT = 794 * MiB, WS_RINV = WS_WRT + 128 * 1024;
typedef float f32x16r __attribute__((ext_vector_type(16)));
__device__ __forceinline__ float swap32f(float x) { const unsigned u = __float_as_uint(x); auto rr = __builtin_amdgcn_permlane32_swap(u, u, false, false); return __uint_as_float(rr[0] ^ rr[1] ^ u); }
__device__ __forceinline__ int swap32i(int x) { const unsigned u = (unsigned)x; auto rr = __builtin_amdgcn_permlane32_swap(u, u, false, false); return (int)(rr[0] ^ rr[1] ^ u); }
static_assert(T == 2048 * 8, "row phases: 8 consecutive rows per wave on a 256-workgroup grid");

__device__ __forceinline__ void r2_p0_rows(Frame& F) {
    const int gw = F.vcu * NWAVES + F.wave, lane = F.lane;
#pragma unroll 1
    for (int hf = 0; hf < 2; ++hf) {
        const int m0 = gw * 8 + hf * 4;
        f32x4 v[4][4]; float s[4];
#pragma unroll
        for (int r = 0; r < 4; ++r) { const GAS f32x4* xr = (const GAS f32x4*)(F.x + (size_t)(m0 + r) * D) + lane;
#pragma unroll
            for (int j = 0; j < 4; ++j) v[r][j] = __builtin_nontemporal_load(xr + 64 * j); }
#pragma unroll
        for (int r = 0; r < 4; ++r) { s[r] = 0.f;
#pragma unroll
            for (int j = 0; j < 4; ++j) s[r] += (v[r][j].x * v[r][j].x + v[r][j].y * v[r][j].y) + (v[r][j].z * v[r][j].z + v[r][j].w * v[r][j].w); }
#pragma unroll
        for (int o = 1; o < 64; o <<= 1) {
#pragma unroll
            for (int r = 0; r < 4; ++r) s[r] += __shfl_xor(s[r], o); }
#pragma unroll
        for (int r = 0; r < 4; ++r) { const float rr = 1.0f / sqrtf(s[r] * (1.f / D) + EPS); GAS v2u* o8 = (GAS v2u*)(F.XN + (size_t)(m0 + r) * D) + lane;
#pragma unroll
            for (int j = 0; j < 4; ++j) { v2u w; w.x = pk2(v[r][j].x * rr, v[r][j].y * rr); w.y = pk2(v[r][j].z * rr, v[r][j].w * rr); o8[64 * j] = w; } }
    }
}
__device__ __forceinline__ void r2_p0_wrt(Frame& F) {
    float* WRT = (float*)(F.ws + WS_WRT);
    const int gt = blockIdx.x * NTHR + F.tid, NT = F.G * NTHR;
    for (int i = gt; i < NE * D; i += NT) { const int e = i >> 10, k = i & (D - 1); WRT[i] = F.w_router[k * NE + e] * F.g_moe[k]; }
}
__device__ __forceinline__ void r2_route(Frame& F) {
    volatile LAS unsigned* lcnt = (volatile LAS unsigned*)(F.lds + L_LCNT);
    if (F.tid < 64) lcnt[F.tid] = 0u;
    __syncthreads();
    const int lane = F.lane, t = lane & 31, kh = lane >> 5;
    const bool active = F.wave < 2;
    int te[4]; unsigned tp[4]; int m = 0;
#pragma unroll
    for (int k = 0; k < 4; ++k) { te[k] = 0; tp[k] = 0u; }
    if (active) {
        const int tile = F.wave * 256 + F.vcu;
        m = tile * 32 + t;
        const GAS f32x4* hrow = (const GAS f32x4*)(F.H1 + (size_t)m * D + kh * 512);
        const GAS f32x4* wrow = (const GAS f32x4*)((const float*)(F.ws + WS_WRT) + (size_t)t * D + kh * 512);
        f32x16r acc = f32x16r{}; float ssq = 0.f;
#pragma unroll 8
        for (int i = 0; i < 128; ++i) {
            const f32x4 hv = hrow[i], wv = wrow[i];
            ssq += (hv.x * hv.x + hv.y * hv.y) + (hv.z * hv.z + hv.w * hv.w);
            acc = __builtin_amdgcn_mfma_f32_32x32x2f32(wv.x, hv.x, acc, 0, 0, 0); acc = __builtin_amdgcn_mfma_f32_32x32x2f32(wv.y, hv.y, acc, 0, 0, 0);
            acc = __builtin_amdgcn_mfma_f32_32x32x2f32(wv.z, hv.z, acc, 0, 0, 0); acc = __builtin_amdgcn_mfma_f32_32x32x2f32(wv.w, hv.w, acc, 0, 0, 0);
        }
        ssq += swap32f(ssq);
        const float rinv = 1.0f / sqrtf(ssq * (1.f / D) + EPS);
        if (kh == 0) ((float*)(F.ws + WS_RINV))[m] = rinv;
        float lg[16];
#pragma unroll
        for (int g = 0; g < 4; ++g) { const f32x4 bv = *(const GAS f32x4*)(F.b_router + 8 * g + 4 * kh);
            lg[4 * g + 0] = acc[4 * g + 0] * rinv + bv.x; lg[4 * g + 1] = acc[4 * g + 1] * rinv + bv.y; lg[4 * g + 2] = acc[4 * g + 2] * rinv + bv.z; lg[4 * g + 3] = acc[4 * g + 3] * rinv + bv.w; }
        float A0, A1, A2, A3; int I0, I1, I2, I3;
        { float vv[4]; int ii[4];
#pragma unroll
          for (int k = 0; k < 4; ++k) { float bv = lg[0]; int bi = 0;
#pragma unroll
              for (int r = 1; r < 16; ++r) if (lg[r] > bv) { bv = lg[r]; bi = r; }
              vv[k] = bv; ii[k] = (bi & 3) + 8 * (bi >> 2) + 4 * kh;
#pragma unroll
              for (int r = 0; r < 16; ++r) if (r == bi) lg[r] = -INFINITY; }
          A0 = vv[0]; A1 = vv[1]; A2 = vv[2]; A3 = vv[3]; I0 = ii[0]; I1 = ii[1]; I2 = ii[2]; I3 = ii[3]; }
        float B0 = swap32f(A0), B1 = swap32f(A1), B2 = swap32f(A2), B3 = swap32f(A3); int J0 = swap32i(I0), J1 = swap32i(I1), J2 = swap32i(I2), J3 = swap32i(I3);
        float tv[4];
#pragma unroll
        for (int k = 0; k < 4; ++k) {
            const bool ta = (A0 > B0) || (A0 == B0 && I0 < J0);
            tv[k] = ta ? A0 : B0; te[k] = ta ? I0 : J0;
            if (ta) { A0 = A1; A1 = A2; A2 = A3; A3 = -INFINITY; I0 = I1; I1 = I2; I2 = I3; } else { B0 = B1; B1 = B2; B2 = B3; B3 = -INFINITY; J0 = J1; J1 = J2; J2 = J3; }
        }
        float g[4], gs = 0.f;
#pragma unroll
        for (int k = 0; k < 4; ++k) { g[k] = __expf(tv[k] - tv[0]); gs += g[k]; }
        const float rg = 1.0f / gs;
        if (kh == 0) {
#pragma unroll
            for (int k = 0; k < 4; ++k) { tp[k] = __hip_atomic_fetch_add((LAS unsigned*)(F.lds + L_LCNT) + te[k], 1u, __ATOMIC_RELAXED, __HIP_MEMORY_SCOPE_WORKGROUP);
                F.topk_e[m * 4 + k] = te[k]; F.gate[m * 4 + k] = g[k] * rg; }
        }
    }
    __syncthreads();
    if (F.tid < 32) lcnt[32 + F.tid] = __hip_atomic_fetch_add((unsigned*)(F.ctl + CW_CNT) + F.tid, lcnt[F.tid], RLX_AGENT);
    __syncthreads();
    if (active && kh == 0) {
#pragma unroll
        for (int k = 0; k < 4; ++k) F.lpos[m * 4 + k] = (int)(tp[k] + lcnt[32 + te[k]]);
    }
}
__device__ __forceinline__ void r2_gather(Frame& F) {
    build_tstart(F);
    const volatile LAS int* ts = (const volatile LAS int*)(F.lds + L_TSTART);
    const int gw = F.vcu * NWAVES + F.wave, lane = F.lane;
    int sl = 0;
    if (lane < 32) { const int mm = gw * 8 + (lane >> 2); const int e = F.topk_e[mm * 4 + (lane & 3)]; sl = ts[e] * 256 + F.lpos[mm * 4 + (lane & 3)]; F.slot[mm * 4 + (lane & 3)] = sl; }
    const float* RINV = (const float*)(F.ws + WS_RINV);
#pragma unroll 1
    for (int hf = 0; hf < 2; ++hf) {
        const int m0 = gw * 8 + hf * 4;
        f32x4 v[4][2][2];
#pragma unroll
        for (int r = 0; r < 4; ++r)
#pragma unroll
            for (int j = 0; j < 2; ++j) { const GAS f32x4* hp = (const GAS f32x4*)(F.H1 + (size_t)(m0 + r) * D + 512 * j + 8 * lane); v[r][j][0] = hp[0]; v[r][j][1] = hp[1]; }
#pragma unroll
        for (int r = 0; r < 4; ++r) { const float rr = RINV[m0 + r];
            v4u w[2];
#pragma unroll
            for (int j = 0; j < 2; ++j) { w[j].x = pk2(v[r][j][0].x * rr, v[r][j][0].y * rr); w[j].y = pk2(v[r][j][0].z * rr, v[r][j][0].w * rr); w[j].z = pk2(v[r][j][1].x * rr, v[r][j][1].y * rr); w[j].w = pk2(v[r][j][1].z * rr, v[r][j][1].w * rr); }
#pragma unroll
            for (int k = 0; k < 4; ++k) { const int s = hf ? __builtin_amdgcn_readlane(sl, 16 + r * 4 + k) : __builtin_amdgcn_readlane(sl, r * 4 + k);
                GAS v4u* dst = (GAS v4u*)(F.XG + (size_t)s * D + 8 * lane); dst[0] = w[0]; dst[64] = w[1]; } }
    }
}
__device__ __forceinline__ void r2_combine(Frame& F) {
    const int gw = F.vcu * NWAVES + F.wave, lane = F.lane;
    int sl = 0; float gt = 0.f;
    if (lane < 32) { const int mm = gw * 8 + (lane >> 2); sl = F.slot[mm * 4 + (lane & 3)]; gt = F.gate[mm * 4 + (lane & 3)]; }
#pragma unroll 1
    for (int q = 0; q < 4; ++q) {
        const int m0 = gw * 8 + q * 2;
        f32x4 h[2][2][2]; v4u y[2][4][2]; float g[2][4];
#pragma unroll
        for (int r = 0; r < 2; ++r) {
#pragma unroll
            for (int k = 0; k < 4; ++k) {
                int s; float gg;
                if (q == 0) { s = __builtin_amdgcn_readlane(sl, r * 4 + k); gg = __uint_as_float(__builtin_amdgcn_readlane(__float_as_uint(gt), r * 4 + k)); }
                else if (q == 1) { s = __builtin_amdgcn_readlane(sl, 8 + r * 4 + k); gg = __uint_as_float(__builtin_amdgcn_readlane(__float_as_uint(gt), 8 + r * 4 + k)); }
                else if (q == 2) { s = __builtin_amdgcn_readlane(sl, 16 + r * 4 + k); gg = __uint_as_float(__builtin_amdgcn_readlane(__float_as_uint(gt), 16 + r * 4 + k)); }
                else { s = __builtin_amdgcn_readlane(sl, 24 + r * 4 + k); gg = __uint_as_float(__builtin_amdgcn_readlane(__float_as_uint(gt), 24 + r * 4 + k)); }
                g[r][k] = gg;
#pragma unroll
                for (int j = 0; j < 2; ++j) y[r][k][j] = *(const GAS v4u*)(F.Yb + (size_t)s * D + 512 * j + 8 * lane);
            }
#pragma unroll
            for (int j = 0; j < 2; ++j) { const GAS f32x4* hp = (const GAS f32x4*)(F.H1 + (size_t)(m0 + r) * D + 512 * j + 8 * lane); h[r][j][0] = hp[0]; h[r][j][1] = hp[1]; }
        }
        float s2[2];
#pragma unroll
        for (int r = 0; r < 2; ++r) { s2[r] = 0.f;
#pragma unroll
            for (int j = 0; j < 2; ++j) {
#pragma unroll
                for (int k = 0; k < 4; ++k) { const v4u yy = y[r][k][j]; const float gg = g[r][k];
                    h[r][j][0].x += gg * bflo(yy.x); h[r][j][0].y += gg * bfhi(yy.x); h[r][j][0].z += gg * bflo(yy.y); h[r][j][0].w += gg * bfhi(yy.y);
                    h[r][j][1].x += gg * bflo(yy.z); h[r][j][1].y += gg * bfhi(yy.z); h[r][j][1].z += gg * bflo(yy.w); h[r][j][1].w += gg * bfhi(yy.w); }
                GAS f32x4* hp = (GAS f32x4*)(F.H1 + (size_t)(m0 + r) * D + 512 * j + 8 * lane); hp[0] = h[r][j][0]; hp[1] = h[r][j][1];
#pragma unroll
                for (int i = 0; i < 2; ++i) s2[r] += (h[r][j][i].x * h[r][j][i].x + h[r][j][i].y * h[r][j][i].y) + (h[r][j][i].z * h[r][j][i].z + h[r][j][i].w * h[r][j][i].w);
            } }
#pragma unroll
        for (int o = 1; o < 64; o <<= 1) { s2[0] += __shfl_xor(s2[0], o); s2[1] += __shfl_xor(s2[1], o); }
#pragma unroll
        for (int r = 0; r < 2; ++r) { const float rr = 1.0f / sqrtf(s2[r] * (1.f / D) + EPS);
#pragma unroll
            for (int j = 0; j < 2; ++j) { v4u w; w.x = pk2(h[r][j][0].x * rr, h[r][j][0].y * rr); w.y = pk2(h[r][j][0].z * rr, h[r][j][0].w * rr); w.z = pk2(h[r][j][1].x * rr, h[r][j][1].y * rr); w.w = pk2(h[r][j][1].z * rr, h[r][j][1].w * rr);
                *(GAS v4u*)(F.XN + (size_t)(m0 + r) * D + 512 * j + 8 * lane) = w; } }
    }
}
__device__ __forceinline__ void r2_final(Frame& F) {
    const int gw = F.vcu * NWAVES + F.wave, lane = F.lane;
    f32x4 gf[4];
#pragma unroll
    for (int j = 0; j < 4; ++j) gf[j] = ((const GAS f32x4*)F.g_final)[64 * j + lane];
#pragma unroll 1
    for (int hf = 0; hf < 2; ++hf) {
        const int m0 = gw * 8 + hf * 4;
        f32x4 v[4][4]; float s[4];
#pragma unroll
        for (int r = 0; r < 4; ++r) { const GAS f32x4* xr = (const GAS f32x4*)(F.out + (size_t)(m0 + r) * D) + lane;
#pragma unroll
            for (int j = 0; j < 4; ++j) v[r][j] = xr[64 * j]; }
#pragma unroll
        for (int r = 0; r < 4; ++r) { s[r] = 0.f;
#pragma unroll
            for (int j = 0; j < 4; ++j) s[r] += (v[r][j].x * v[r][j].x + v[r][j].y * v[r][j].y) + (v[r][j].z * v[r][j].z + v[r][j].w * v[r][j].w); }
#pragma unroll
        for (int o = 1; o < 64; o <<= 1) {
#pragma unroll
            for (int r = 0; r < 4; ++r) s[r] += __shfl_xor(s[r], o); }
#pragma unroll
        for (int r = 0; r < 4; ++r) { const float rr = 1.0f / sqrtf(s[r] * (1.f / D) + EPS); GAS f32x4* xr = (GAS f32x4*)(F.out + (size_t)(m0 + r) * D) + lane;
#pragma unroll
            for (int j = 0; j < 4; ++j) xr[64 * j] = v[r][j] * rr * gf[j]; }
    }
}

namespace pg8 {
#define PG8_LAS __attribute__((address_space(3)))
typedef unsigned short bf16_t;
typedef short bf16x8 __attribute__((ext_vector_type(8)));
typedef unsigned u32x4 __attribute__((ext_vector_type(4)));
typedef unsigned u32x2 __attribute__((ext_vector_type(2)));
constexpr int BM = 256, BK = 64, HALF = 128, HTB = HALF * BK * 2, STAGE_BYTES = 8 * HTB, NXCD = 8, WGM = 8;
__host__ __device__ __forceinline__ int lds_byte(int r, int c) { const int st = (r >> 4) * 2 + (c >> 5), rr = r & 15, cc = c & 31, ob = rr * 64 + cc * 2; return st * 1024 + (ob ^ (((ob >> 9) & 1) << 5)); }
__host__ __device__ __forceinline__ void stage_rc(int b, int& R, int& C) { const int st = b / 1024, sb = b % 1024, swz = sb ^ (((sb >> 9) & 1) << 5); R = (st >> 1) * 16 + swz / 64; C = (st & 1) * 32 + (swz % 64) / 2; }
__host__ __device__ __forceinline__ int perm32(int rho) { const int n = rho >> 4, i = rho & 15; return 8 * (i >> 2) + 4 * n + (i & 3); }

struct Unit { int pm, pn, pb, e; };
struct Gemm { const bf16_t* A; int lda; const bf16_t* Bt; int ldb; int K; };

struct StaticOrder {
    int nM, nN, nwg, G, c;
    __device__ void init(int nM_, int nN_, int G_, int c_) { nM = nM_; nN = nN_; nwg = nM * nN; G = G_; c = c_; }
    __device__ bool next(int i, Unit& u) const {
        const long L = (long)i * G + c; if (c < 0 || L >= nwg) return false;
        int wgid = (int)L; { const int q = nwg / NXCD, r = nwg % NXCD, xcd = wgid % NXCD, off = wgid / NXCD; wgid = (xcd < r ? xcd * (q + 1) : r * (q + 1) + (xcd - r) * q) + off; }
        const int nig = WGM * nN, gid = wgid / nig, fm = gid * WGM, gsz = (nM - fm) < WGM ? (nM - fm) : WGM;
        u.pm = fm + ((wgid % nig) % gsz); u.pn = (wgid % nig) / gsz; u.pb = u.pn; u.e = 0; return true;
    }
};
struct GroupedOrder : StaticOrder {
    const volatile PG8_LAS int* ts;
    __device__ bool next(int i, Unit& u) const {
        if (!StaticOrder::next(i, u)) return false;
        int e = 0;
        for (int j = 1; j < 32; ++j) e = (u.pm >= ts[j]) ? j : e;
        u.e = e; u.pb = e * nN + u.pn; return true;
    }
};

__device__ __forceinline__ unsigned cvt_pk_bf16(float lo, float hi) { unsigned r; asm volatile("v_cvt_pk_bf16_f32 %0, %1, %2" : "=v"(r) : "v"(lo), "v"(hi)); return r; }
__device__ __forceinline__ u32x4 pack8(const f32x4& a, const f32x4& b) { u32x4 w; w.x = cvt_pk_bf16(a[0], a[1]); w.y = cvt_pk_bf16(a[2], a[3]); w.z = cvt_pk_bf16(b[0], b[1]); w.w = cvt_pk_bf16(b[2], b[3]); return w; }
__device__ __forceinline__ float psum8(const float* p) { const f32x4 a = *(const f32x4*)p, b = *(const f32x4*)(p + 4); return ((a[0] + a[1]) + (a[2] + a[3])) + ((b[0] + b[1]) + (b[2] + b[3])); }
__device__ __forceinline__ void rope8(f32x4& a, f32x4& b, const f32x4& c, const f32x4& s) {
    const float a0 = a[0] * c[0] - a[1] * s[0], a1 = a[1] * c[0] + a[0] * s[0], a2 = a[2] * c[1] - a[3] * s[1], a3 = a[3] * c[1] + a[2] * s[1];
    const float b0 = b[0] * c[2] - b[1] * s[2], b1 = b[1] * c[2] + b[0] * s[2], b2 = b[2] * c[3] - b[3] * s[3], b3 = b[3] * c[3] + b[2] * s[3];
    a = (f32x4){a0, a1, a2, a3}; b = (f32x4){b0, b1, b2, b3};
}
struct EpiStoreBf16 {
    static constexpr bool PERM = true, AFTER_DRAIN = false, HAS_MID = false;
    bf16_t* O; int ldc;
    __device__ __forceinline__ void operator()(const f32x4 (&acc)[2][2][4][2], const Unit& u, int wr, int wc, int fr, int fq) const {
        const int row0 = u.pm * BM + wr * 64 + fr, col0 = u.pn * BM + wc * 32 + 8 * fq;
#pragma unroll
        for (int ai = 0; ai < 2; ++ai)
#pragma unroll
            for (int m = 0; m < 4; ++m) { bf16_t* rowp = O + (size_t)(row0 + ai * HALF + m * 16) * ldc + col0;
#pragma unroll
                for (int bj = 0; bj < 2; ++bj) *(u32x4*)(rowp + bj * HALF) = pack8(acc[ai][bj][m][0], acc[ai][bj][m][1]); }
    }
};
struct EpiInProj {
    static constexpr bool PERM = true, AFTER_DRAIN = false, HAS_MID = false;
    bf16_t* Y; float* PA; const float* COS; const float* SIN;
    __device__ __forceinline__ void operator()(const f32x4 (&acc)[2][2][4][2], const Unit& u, int wr, int wc, int fr, int fq) const {
        const int row0 = u.pm * BM + wr * 64 + fr, col0 = u.pn * BM + wc * 32 + 8 * fq;
        const bool rope = (u.pn == 2 && wc == 0);
#pragma unroll
        for (int ai = 0; ai < 2; ++ai)
#pragma unroll
            for (int m = 0; m < 4; ++m) {
                const int row = row0 + ai * HALF + m * 16;
                f32x4 v00 = acc[ai][0][m][0], v01 = acc[ai][0][m][1], v10 = acc[ai][1][m][0], v11 = acc[ai][1][m][1];
                if (u.pn <= 2) {
                    float s0 = ((v00[0] * v00[0] + v00[1] * v00[1]) + (v00[2] * v00[2] + v00[3] * v00[3])) + ((v01[0] * v01[0] + v01[1] * v01[1]) + (v01[2] * v01[2] + v01[3] * v01[3]));
                    float s1 = ((v10[0] * v10[0] + v10[1] * v10[1]) + (v10[2] * v10[2] + v10[3] * v10[3])) + ((v11[0] * v11[0] + v11[1] * v11[1]) + (v11[2] * v11[2] + v11[3] * v11[3]));
                    s0 += __shfl_xor(s0, 16); s0 += __shfl_xor(s0, 32); s1 += __shfl_xor(s1, 16); s1 += __shfl_xor(s1, 32);
                    if (fq == 0) {
                        if (u.pn == 0) PA[(size_t)row * 16 + wc] = s0 + s1;
                        else if (u.pn == 1) { PA[(size_t)row * 16 + 4 + wc] = s0; PA[(size_t)row * 16 + 8 + wc] = s1; }
                        else PA[(size_t)row * 16 + 12 + wc] = s0;
                    }
                }
                if (rope) { const f32x4 c = *(const f32x4*)(COS + (size_t)row * 16 + 4 * fq), s = *(const f32x4*)(SIN + (size_t)row * 16 + 4 * fq); rope8(v10, v11, c, s); }
                bf16_t* rowp = Y + (size_t)row * NINP + col0;
                *(u32x4*)(rowp) = pack8(v00, v01); *(u32x4*)(rowp + HALF) = pack8(v10, v11);
            }
    }
};
struct EpiQ {
    static constexpr bool PERM = true, AFTER_DRAIN = false, HAS_MID = false;
    bf16_t* Q; const float* PA; const float* COS; const float* SIN;
    __device__ __forceinline__ void operator()(const f32x4 (&acc)[2][2][4][2], const Unit& u, int wr, int wc, int fr, int fq) const {
        const int row0 = u.pm * BM + wr * 64 + fr, col0 = u.pn * BM + wc * 32 + 8 * fq;
        const bool rope0 = ((8 * u.pn + wc) % 3) == 2, rope1 = ((8 * u.pn + 4 + wc) % 3) == 2;
#pragma unroll
        for (int ai = 0; ai < 2; ++ai)
#pragma unroll
            for (int m = 0; m < 4; ++m) {
                const int row = row0 + ai * HALF + m * 16;
                const float rinv = 1.0f / sqrtf(psum8(PA + (size_t)row * 16) * (1.f / QLR) + EPS);
                f32x4 v00 = acc[ai][0][m][0] * rinv, v01 = acc[ai][0][m][1] * rinv, v10 = acc[ai][1][m][0] * rinv, v11 = acc[ai][1][m][1] * rinv;
                if (rope0 || rope1) { const f32x4 c = *(const f32x4*)(COS + (size_t)row * 16 + 4 * fq), s = *(const f32x4*)(SIN + (size_t)row * 16 + 4 * fq);
                    if (rope0) rope8(v00, v01, c, s); if (rope1) rope8(v10, v11, c, s); }
                bf16_t* rowp = Q + (size_t)row * (HM * QKD) + col0;
                *(u32x4*)(rowp) = pack8(v00, v01); *(u32x4*)(rowp + HALF) = pack8(v10, v11);
                asm volatile("" ::: "memory");
            }
    }
};
struct EpiKV {
    static constexpr bool PERM = true, AFTER_DRAIN = false, HAS_MID = false;
    bf16_t* KNp; bf16_t* VMp; const float* PA;
    __device__ __forceinline__ void operator()(const f32x4 (&acc)[2][2][4][2], const Unit& u, int wr, int wc, int fr, int fq) const {
        const int row0 = u.pm * BM + wr * 64 + fr, col0 = (u.pn & 1) * BM + wc * 32 + 8 * fq;
        bf16_t* base = (u.pn < 2) ? KNp : VMp;
#pragma unroll
        for (int ai = 0; ai < 2; ++ai)
#pragma unroll
            for (int m = 0; m < 4; ++m) {
                const int row = row0 + ai * HALF + m * 16;
                const float rinv = 1.0f / sqrtf(psum8(PA + (size_t)row * 16 + 8) * (1.f / KVLR) + EPS);
                bf16_t* rowp = base + (size_t)row * 512 + col0;
#pragma unroll
                for (int bj = 0; bj < 2; ++bj) *(u32x4*)(rowp + bj * HALF) = pack8(acc[ai][bj][m][0] * rinv, acc[ai][bj][m][1] * rinv);
                asm volatile("" ::: "memory");
            }
    }
};
struct EpiWo {
    static constexpr bool PERM = false, AFTER_DRAIN = false, HAS_MID = true;
    const float* X; float* H; const float* PO; PG8_LAS float* RAT; PG8_LAS float* RS;
    __device__ __forceinline__ void begin(const Unit& u, int t) const {
        if (t < 256) { const int row = u.pm * BM + t;
            const float rm = 1.0f / sqrtf(psum8(PO + (size_t)row * 16) * (1.f / 512) + EPS), rs = 1.0f / sqrtf(psum8(PO + (size_t)row * 16 + 8) * (1.f / 512) + EPS);
            RAT[t] = rm / rs; RS[t] = rs; }
    }
    __device__ __forceinline__ void mid(f32x4 (&acc)[2][2][4][2], int wr, int fr) const {
#pragma unroll
        for (int ai = 0; ai < 2; ++ai)
#pragma unroll
            for (int m = 0; m < 4; ++m) { const float f = RAT[ai * HALF + wr * 64 + m * 16 + fr];
#pragma unroll
                for (int bj = 0; bj < 2; ++bj)
#pragma unroll
                    for (int n = 0; n < 2; ++n) acc[ai][bj][m][n] = acc[ai][bj][m][n] * f; }
    }
    __device__ __forceinline__ void operator()(const f32x4 (&acc)[2][2][4][2], const Unit& u, int wr, int wc, int fr, int fq) const {
        const int row0 = u.pm * BM + wr * 64 + fr, col0 = u.pn * BM + wc * 32 + 4 * fq;
#pragma unroll
        for (int ai = 0; ai < 2; ++ai)
#pragma unroll
            for (int m = 0; m < 4; ++m) { const float rs = RS[ai * HALF + wr * 64 + m * 16 + fr]; const size_t off = (size_t)(row0 + ai * HALF + m * 16) * D + col0;
#pragma unroll
                for (int bj = 0; bj < 2; ++bj)
#pragma unroll
                    for (int n = 0; n < 2; ++n) { const f32x4 xv = *(const f32x4*)(X + off + bj * HALF + n * 16); *(f32x4*)(H + off + bj * HALF + n * 16) = xv + acc[ai][bj][m][n] * rs; } }
    }
};
struct EpiGu {
    static constexpr bool PERM = true, AFTER_DRAIN = false, HAS_MID = false;
    bf16_t* ACTp; const float* bgu;
    __device__ __forceinline__ void operator()(const f32x4 (&acc)[2][2][4][2], const Unit& u, int wr, int wc, int fr, int fq) const {
        const int row0 = u.pm * BM + wr * 64 + fr, cg = u.pn * HALF + wc * 32 + 8 * fq;
        const float* bb = bgu + (size_t)u.e * (2 * DFF) + cg;
        const f32x4 bg0 = *(const f32x4*)(bb), bg1 = *(const f32x4*)(bb + 4), bl0 = *(const f32x4*)(bb + DFF), bl1 = *(const f32x4*)(bb + DFF + 4);
#pragma unroll
        for (int ai = 0; ai < 2; ++ai)
#pragma unroll
            for (int m = 0; m < 4; ++m) {
                f32x4 o[2];
#pragma unroll
                for (int n = 0; n < 2; ++n) { const f32x4 g4 = acc[ai][0][m][n] + (n ? bg1 : bg0), l4 = acc[ai][1][m][n] + (n ? bl1 : bl0);
#pragma unroll
                    for (int i = 0; i < 4; ++i) { const float g = fminf(g4[i], 7.0f), l = fminf(fmaxf(l4[i], -7.0f), 7.0f);
                        o[n][i] = g * __builtin_amdgcn_rcpf(1.0f + __builtin_amdgcn_exp2f(-1.702f * LOG2E * g)) * (l + 1.0f); } }
                *(u32x4*)(ACTp + (size_t)(row0 + ai * HALF + m * 16) * DFF + cg) = pack8(o[0], o[1]);
            }
    }
};
struct EpiDn {
    static constexpr bool PERM = true, AFTER_DRAIN = false, HAS_MID = false;
    bf16_t* Yp; const float* bdn;
    __device__ __forceinline__ void operator()(const f32x4 (&acc)[2][2][4][2], const Unit& u, int wr, int wc, int fr, int fq) const {
        const int row0 = u.pm * BM + wr * 64 + fr, col0 = u.pn * BM + wc * 32 + 8 * fq;
        const float* bb = bdn + (size_t)u.e * D + col0;
        f32x4 bv[2][2];
#pragma unroll
        for (int bj = 0; bj < 2; ++bj)
#pragma unroll
            for (int n = 0; n < 2; ++n) bv[bj][n] = *(const f32x4*)(bb + bj * HALF + 4 * n);
#pragma unroll
        for (int ai = 0; ai < 2; ++ai)
#pragma unroll
            for (int m = 0; m < 4; ++m) { bf16_t* rowp = Yp + (size_t)(row0 + ai * HALF + m * 16) * D + col0;
#pragma unroll
                for (int bj = 0; bj < 2; ++bj) *(u32x4*)(rowp + bj * HALF) = pack8(acc[ai][bj][m][0] + bv[bj][0], acc[ai][bj][m][1] + bv[bj][1]); }
    }
};
struct EpiGate {
    static constexpr bool PERM = false, AFTER_DRAIN = false, HAS_MID = false;
    const float* H; const bf16_t* PR; float* OUT;
    __device__ __forceinline__ void operator()(const f32x4 (&acc)[2][2][4][2], const Unit& u, int wr, int wc, int fr, int fq) const {
        const int row0 = u.pm * BM + wr * 64 + fr, col0 = u.pn * BM + wc * 32 + 4 * fq;
#pragma unroll
        for (int ai = 0; ai < 2; ++ai)
#pragma unroll
            for (int m = 0; m < 4; ++m) { const size_t off = (size_t)(row0 + ai * HALF + m * 16) * D + col0;
#pragma unroll
                for (int bj = 0; bj < 2; ++bj)
#pragma unroll
                    for (int n = 0; n < 2; ++n) { const size_t o2 = off + bj * HALF + n * 16; const f32x4 hv = *(const f32x4*)(H + o2); const u32x2 pw = *(const u32x2*)(PR + o2); const f32x4 a = acc[ai][bj][m][n];
                        f32x4 r;
                        r[0] = hv[0] + __builtin_amdgcn_rcpf(1.0f + __builtin_amdgcn_exp2f(-LOG2E * a[0])) * __uint_as_float(pw.x << 16);
                        r[1] = hv[1] + __builtin_amdgcn_rcpf(1.0f + __builtin_amdgcn_exp2f(-LOG2E * a[1])) * __uint_as_float(pw.x & 0xffff0000u);
                        r[2] = hv[2] + __builtin_amdgcn_rcpf(1.0f + __builtin_amdgcn_exp2f(-LOG2E * a[2])) * __uint_as_float(pw.y << 16);
                        r[3] = hv[3] + __builtin_amdgcn_rcpf(1.0f + __builtin_amdgcn_exp2f(-LOG2E * a[3])) * __uint_as_float(pw.y & 0xffff0000u);
                        *(f32x4*)(OUT + o2) = r; } }
    }
};

template <class Epi, class Sched, bool ALIGN_EPI>
__device__ __forceinline__ void gemm_phase(PG8_LAS unsigned char* lds, int wave_id, const Gemm g, const Sched& S, const Epi& E) {
    const int wid = wave_id, lane = lane_id(), tid = wid * 64 + lane, wr = wid >> 2, wc = wid & 3, fr = lane & 15, fq = lane >> 4;
    const int K = g.K, nt = K / BK;
    unsigned voffA[2], voffB[2];
#pragma unroll
    for (int i = 0; i < 2; ++i) { int R, C; stage_rc(tid * 16 + i * 8192, R, C); const int Rb = Epi::PERM ? ((R & ~31) + perm32(R & 31)) : R;
        voffA[i] = (unsigned)(R * g.lda + C) * 2u; voffB[i] = (unsigned)(Rb * g.ldb + C) * 2u; }
    const size_t kstep = (size_t)(BK * 2);
    const size_t hstepA = (size_t)HALF * g.lda * 2, hstepB = (size_t)HALF * g.ldb * 2;
    const size_t tstepA = 2 * hstepA, tstepB = 2 * hstepB;
    const unsigned ldsw = (unsigned)wid * 1024u;
    const int aoff = lds_byte(wr * 64 + fr, fq * 8), boff = lds_byte(wc * 32 + fr, fq * 8);
#define PG8_SA(b, h) (((b) * 2 + (h)) * HTB)
#define PG8_SB(b, h) ((4 + (b) * 2 + (h)) * HTB)
#define PG8_STAGE(bufoff, gbase, voff) do { _Pragma("unroll") for (int _i = 0; _i < 2; ++_i) \
        __builtin_amdgcn_global_load_lds((const unsigned*)((const char*)(gbase) + (voff)[_i]), (PG8_LAS unsigned*)(lds + (bufoff) + ldsw + _i * 8192), 16, 0, 0); } while (0)
#define PG8_LDA(dst, b, h) do { _Pragma("unroll") for (int m = 0; m < 4; ++m) _Pragma("unroll") for (int k = 0; k < 2; ++k) dst[m][k] = *(const PG8_LAS bf16x8*)(lds + PG8_SA(b, h) + aoff + m * 2048 + k * 1024); } while (0)
#define PG8_LDB(dst, b, h) do { _Pragma("unroll") for (int n = 0; n < 2; ++n) _Pragma("unroll") for (int k = 0; k < 2; ++k) dst[n][k] = *(const PG8_LAS bf16x8*)(lds + PG8_SB(b, h) + boff + n * 2048 + k * 1024); } while (0)
#define PG8_MMA(ai, bj, At, Bt) do { __builtin_amdgcn_s_setprio(1); _Pragma("unroll") for (int m = 0; m < 4; ++m) _Pragma("unroll") for (int n = 0; n < 2; ++n) _Pragma("unroll") for (int k = 0; k < 2; ++k) \
        acc[ai][bj][m][n] = __builtin_amdgcn_mfma_f32_16x16x32_bf16(Bt[n][k], At[m][k], acc[ai][bj][m][n], 0, 0, 0); __builtin_amdgcn_s_setprio(0); } while (0)
#define PG8_WAIT_V(n) asm volatile("s_waitcnt vmcnt(" #n ")" ::: "memory")
#define PG8_WAIT_L(n) asm volatile("s_waitcnt lgkmcnt(" #n ")" ::: "memory")
#define PG8_BAR __builtin_amdgcn_s_barrier()
#define PG8_SCHED __builtin_amdgcn_sched_barrier(0)
    Unit cur, nxt; int ui = 0;
    if (!S.next(0, cur)) return;
    f32x4 acc[2][2][4][2];
#pragma unroll
    for (int a = 0; a < 2; ++a)
#pragma unroll
        for (int b = 0; b < 2; ++b)
#pragma unroll
            for (int m = 0; m < 4; ++m)
#pragma unroll
                for (int n = 0; n < 2; ++n) acc[a][b][m][n] = (f32x4){0.f, 0.f, 0.f, 0.f};
    bf16x8 At[4][2], B0[2][2], B1[2][2];
    const char* cA = (const char*)g.A + (size_t)cur.pm * tstepA; const char* cB = (const char*)g.Bt + (size_t)cur.pb * tstepB;
    if constexpr (Epi::HAS_MID) E.begin(cur, tid);
    PG8_STAGE(PG8_SB(0, 0), cB, voffB); PG8_STAGE(PG8_SB(0, 1), cB + hstepB, voffB); PG8_STAGE(PG8_SA(0, 0), cA, voffA); PG8_STAGE(PG8_SA(0, 1), cA + hstepA, voffA);
    if (wr == 1) PG8_BAR;
    PG8_WAIT_V(2); PG8_BAR;
    PG8_STAGE(PG8_SB(1, 0), cB + kstep, voffB); PG8_STAGE(PG8_SA(1, 0), cA + kstep, voffA); PG8_STAGE(PG8_SB(1, 1), cB + hstepB + kstep, voffB);
    PG8_WAIT_V(6); PG8_BAR;
    for (;;) {
        const bool has_next = S.next(ui + 1, nxt);
        const char* nA = has_next ? (const char*)g.A + (size_t)nxt.pm * tstepA : cA; const char* nB = has_next ? (const char*)g.Bt + (size_t)nxt.pb * tstepB : cB;
        for (int t = 0; t < nt; t += 2) {
            const bool last = (t == nt - 2);
            const char* a1 = cA + (size_t)(t + 1) * kstep;
            const char* a2 = last ? nA : cA + (size_t)(t + 2) * kstep; const char* b2 = last ? nB : cB + (size_t)(t + 2) * kstep;
            const char* a3 = a2 + kstep; const char* b3 = b2 + kstep;
            if constexpr (Epi::HAS_MID) { if (t == nt / 2) E.mid(acc, wr, lane_id() & 15); }
            PG8_LDB(B0, 0, 0); PG8_LDB(B1, 0, 1); PG8_SCHED; PG8_LDA(At, 0, 0); PG8_STAGE(PG8_SA(1, 1), a1 + hstepA, voffA);
            PG8_WAIT_V(8); PG8_WAIT_L(0); PG8_BAR; PG8_MMA(0, 0, At, B0); PG8_MMA(0, 1, At, B1); PG8_BAR; PG8_SCHED;
            PG8_LDA(At, 0, 1); PG8_STAGE(PG8_SB(0, 0), b2, voffB); PG8_STAGE(PG8_SB(0, 1), b2 + hstepB, voffB); PG8_STAGE(PG8_SA(0, 0), a2, voffA);
            PG8_WAIT_V(8); PG8_WAIT_L(0); PG8_BAR; PG8_MMA(1, 0, At, B0); PG8_MMA(1, 1, At, B1); PG8_BAR; PG8_SCHED;
            PG8_LDB(B0, 1, 0); PG8_LDB(B1, 1, 1); PG8_SCHED; PG8_LDA(At, 1, 0); PG8_STAGE(PG8_SA(0, 1), a2 + hstepA, voffA);
            PG8_WAIT_V(8); PG8_WAIT_L(0); PG8_BAR; PG8_MMA(0, 0, At, B0); PG8_MMA(0, 1, At, B1); PG8_BAR; PG8_SCHED;
            PG8_LDA(At, 1, 1); PG8_STAGE(PG8_SB(1, 0), b3, voffB); PG8_STAGE(PG8_SB(1, 1), b3 + hstepB, voffB); PG8_STAGE(PG8_SA(1, 0), a3, voffA);
            PG8_WAIT_V(8); PG8_WAIT_L(0); PG8_BAR; PG8_MMA(1, 0, At, B0); PG8_MMA(1, 1, At, B1); PG8_BAR; PG8_SCHED;
        }
        if constexpr (ALIGN_EPI) { if (wr == 0) PG8_BAR; }
        { const int l2 = lane_id();
          E(acc, cur, wr, wc, l2 & 15, l2 >> 4); }
        if (!has_next) break;
#pragma unroll
        for (int a = 0; a < 2; ++a)
#pragma unroll
            for (int b = 0; b < 2; ++b)
#pragma unroll
                for (int m = 0; m < 4; ++m)
#pragma unroll
                    for (int n = 0; n < 2; ++n) acc[a][b][m][n] = (f32x4){0.f, 0.f, 0.f, 0.f};
        cur = nxt; cA = nA; cB = nB; ++ui;
        if constexpr (ALIGN_EPI) { if (wr == 1) PG8_BAR; }
    }
    PG8_WAIT_V(0);
    if constexpr (!ALIGN_EPI) { if (wr == 0) PG8_BAR; }
    PG8_BAR;
#undef PG8_SA
#undef PG8_SB
#undef PG8_STAGE
#undef PG8_LDA
#undef PG8_LDB
#undef PG8_MMA
#undef PG8_WAIT_V
#undef PG8_WAIT_L
#undef PG8_BAR
#undef PG8_SCHED
}
}

namespace att {
typedef short bf16x8 __attribute__((ext_vector_type(8)));
typedef short s16x4 __attribute__((ext_vector_type(4)));
typedef float f32x16 __attribute__((ext_vector_type(16)));
typedef __attribute__((address_space(3))) const char* lds_cptr;
constexpr int KSLOT = 12288, VSLOT = 8192, LDS_K = 0, LDS_V = 3 * KSLOT, LDS_WS = LDS_V + 3 * VSLOT, LDS_OST = LDS_WS + 8 * 256, LDS_FLAG = LDS_OST + 8 * 4096, ATT_BYTES = LDS_FLAG + 64;
static_assert(ATT_BYTES <= RING_BYTES, "attention LDS");
__device__ __forceinline__ int crow(int r, int hi) { return (r & 3) + 8 * (r >> 2) + 4 * hi; }
__device__ __forceinline__ void glds16(const void* gsrc, unsigned lds_dst) { unsigned keep;
    asm volatile("s_mov_b32 %0, m0\n\ts_mov_b32 m0, %2\n\ts_nop 0\n\tglobal_load_lds_dwordx4 %1, off\n\ts_mov_b32 m0, %0" : "=&s"(keep) : "v"(gsrc), "s"(lds_dst) : "memory"); }
__device__ __forceinline__ s16x4 vtr(lds_cptr p) { typedef short v4i16_t __attribute__((ext_vector_type(4))); return __builtin_bit_cast(s16x4, __builtin_amdgcn_ds_read_tr16_b64_v4i16((__attribute__((address_space(3))) v4i16_t*)p)); }
__device__ __forceinline__ float swap32(float x) { const unsigned u = __float_as_uint(x); auto rr = __builtin_amdgcn_permlane32_swap(u, u, false, false); return __uint_as_float(rr[0] ^ rr[1] ^ u); }
__device__ __forceinline__ bf16x8 pack8(const f32x16& p, int b) { pg8::u32x4 w; w.x = pg8::cvt_pk_bf16(p[b], p[b + 1]); w.y = pg8::cvt_pk_bf16(p[b + 2], p[b + 3]); w.z = pg8::cvt_pk_bf16(p[b + 4], p[b + 5]); w.w = pg8::cvt_pk_bf16(p[b + 6], p[b + 7]); return __builtin_bit_cast(bf16x8, w); }
#define ATT_WAIT_BAR(N) asm volatile("s_waitcnt vmcnt(" #N ") lgkmcnt(0)\n\ts_barrier" ::: "memory")
__device__ __forceinline__ void pv(f32x16 (&o)[2], lds_cptr vp, const bf16x8 (&pa)[4]) {
#pragma unroll
    for (int d0 = 0; d0 < 2; ++d0)
#pragma unroll
        for (int ks = 0; ks < 4; ++ks) { const s16x4 lo = vtr(vp + d0 * 4096 + ks * 1024), hi = vtr(vp + d0 * 4096 + ks * 1024 + 512);
            const bf16x8 vb = (bf16x8){lo[0], lo[1], lo[2], lo[3], hi[0], hi[1], hi[2], hi[3]};
            o[d0] = __builtin_amdgcn_mfma_f32_32x32x16_bf16(pa[ks], vb, o[d0], 0, 0, 0); }
}
__device__ __forceinline__ void store_o(const f32x16 (&o)[2], const float (&rsc)[16], bf16* Ow, int pitch, float* POw, int pslot, LAS unsigned char* shm, int wid, int lane) {
    const int r32 = lane & 31, hi = lane >> 5;
    LAS bf16* stg = (LAS bf16*)(shm + LDS_OST + wid * 4096);
#pragma unroll
    for (int r = 0; r < 16; ++r) { const int orow = crow(r, hi);
#pragma unroll
        for (int d0 = 0; d0 < 2; ++d0) stg[orow * 64 + d0 * 32 + r32] = (bf16)f2bf(o[d0][r] * rsc[r]); }
    asm volatile("s_waitcnt lgkmcnt(0)" ::: "memory");
#pragma unroll
    for (int i = 0; i < 4; ++i) { const int row = i * 8 + (lane >> 3), ch = lane & 7; const v4u v = *(const LAS v4u*)(stg + row * 64 + ch * 8);
        *(GAS v4u*)(Ow + (size_t)row * pitch + ch * 8) = v;
        float s = 0.f;
#pragma unroll
        for (int j = 0; j < 4; ++j) { const float a = bflo(v[j]), b = bfhi(v[j]); s += a * a + b * b; }
        s += __shfl_xor(s, 1); s += __shfl_xor(s, 2); s += __shfl_xor(s, 4);
        if (ch == 0) POw[(size_t)row * 16 + pslot] = s; }
}

__device__ __forceinline__ void mla_unit(Frame& F, int b, int h, int qb, LAS unsigned char* shm) {
    const int wid = F.wave, lane = lane_id(), r32 = lane & 31, hi = lane >> 5;
    const long rowbase = (long)b * SEQ; const int q0 = qb * 256;
    const unsigned lds0 = (unsigned)(uintptr_t)shm;
    LAS float* wsf = (LAS float*)(shm + LDS_WS) + wid * 64;
    const bf16* ksrc = F.KN + (rowbase + lane) * 512 + h * 64 + wid * 8;
    const bf16* rsrc = F.Y1 + (rowbase + lane) * NINP + C_KR + (wid & 3) * 8;
    const bf16* vsrc = F.VM + (rowbase + 16 * (wid & 3) + (lane >> 2)) * 512 + h * 64 + (wid >> 2) * 32 + (lane & 3) * 8;
    const unsigned kdst = lds0 + LDS_K + wid * 1024, rdst = lds0 + LDS_K + (8 + (wid & 3)) * 1024, vdst = lds0 + LDS_V + wid * 1024;
#define MLA_DMA(t, sl) do { glds16(ksrc + (long)(t) * 64 * 512, (unsigned)__builtin_amdgcn_readfirstlane(kdst + (sl) * KSLOT)); glds16(rsrc + (long)(t) * 64 * NINP, (unsigned)__builtin_amdgcn_readfirstlane(rdst + (sl) * KSLOT)); \
        glds16(vsrc + (long)(t) * 64 * 512, (unsigned)__builtin_amdgcn_readfirstlane(vdst + (sl) * VSLOT)); } while (0)
    const int NT = 4 * qb + 4, tl = 4 * qb + (wid >> 1);
    MLA_DMA(0, 0); MLA_DMA(1, 1);
    const bf16* Qw = F.Q + (rowbase + q0 + wid * 32 + r32) * (HM * QKD) + h * QKD + hi * 8;
    bf16x8 qr[6];
#pragma unroll
    for (int d0 = 0; d0 < 6; ++d0) qr[d0] = *(const GAS bf16x8*)(Qw + d0 * 16);
    float m = -1e30f, l = 0.f; f32x16 o[2]; o[0] = f32x16{}; o[1] = f32x16{};
    const int qrel = (wid & 1) * 32 + r32;
    const lds_cptr shm3 = (lds_cptr)shm; const lds_cptr kp0 = shm3 + LDS_K + hi * 1024 + r32 * 16, vp0 = shm3 + LDS_V + ((lane >> 4) & 1) * 32 + (lane & 3) * 8 + (4 * hi + ((lane & 15) >> 2)) * 64;
    int sl = 0, sl2 = 2;
    for (int t = 0; t < NT; ++t) {
        if (t + 1 < NT) ATT_WAIT_BAR(3); else ATT_WAIT_BAR(0);
        if (t + 2 < NT) MLA_DMA(t + 2, sl2);
        if (t <= tl) {
            const lds_cptr kp = kp0 + sl * KSLOT;
            f32x16 p0 = f32x16{}, p1 = f32x16{};
#pragma unroll
            for (int d0 = 0; d0 < 6; ++d0) { const bf16x8 k0 = *(const __attribute__((address_space(3))) bf16x8*)(kp + d0 * 2048), k1 = *(const __attribute__((address_space(3))) bf16x8*)(kp + d0 * 2048 + 512);
                p0 = __builtin_amdgcn_mfma_f32_32x32x16_bf16(k0, qr[d0], p0, 0, 0, 0); p1 = __builtin_amdgcn_mfma_f32_32x32x16_bf16(k1, qr[d0], p1, 0, 0, 0); }
            if (t == tl) {
#pragma unroll
                for (int r = 0; r < 16; ++r) { const int kv = crow(r, hi); if (kv > qrel) p0[r] = -INFINITY; if (kv + 32 > qrel) p1[r] = -INFINITY; }
            }
            float rm = fmaxf(p0[0], p1[0]);
#pragma unroll
            for (int r = 1; r < 16; ++r) rm = fmaxf(rm, fmaxf(p0[r], p1[r]));
            rm = fmaxf(rm, swap32(rm));
            if (__any(rm > m + 8.0f)) {
                const float mn = fmaxf(m, rm), al = __builtin_amdgcn_exp2f(m - mn); m = mn; l *= al;
                if (hi == 0) wsf[r32] = al;
                asm volatile("s_waitcnt lgkmcnt(0)" ::: "memory");
#pragma unroll
                for (int r = 0; r < 16; ++r) { const float f = wsf[crow(r, hi)]; o[0][r] *= f; o[1][r] *= f; }
            }
            float ls = 0.f;
#pragma unroll
            for (int r = 0; r < 16; ++r) { p0[r] = __builtin_amdgcn_exp2f(p0[r] - m); p1[r] = __builtin_amdgcn_exp2f(p1[r] - m); ls += p0[r] + p1[r]; }
            l += ls;
            const bf16x8 pa[4] = {pack8(p0, 0), pack8(p0, 8), pack8(p1, 0), pack8(p1, 8)};
            pv(o, vp0 + sl * VSLOT, pa);
        }
        sl = (sl == 2) ? 0 : sl + 1; sl2 = (sl2 == 2) ? 0 : sl2 + 1;
    }
#undef MLA_DMA
    l += swap32(l);
    if (hi == 0) wsf[32 + r32] = l;
    asm volatile("s_waitcnt lgkmcnt(0)" ::: "memory");
    float rli[16];
#pragma unroll
    for (int r = 0; r < 16; ++r) rli[r] = __builtin_amdgcn_rcpf(wsf[32 + crow(r, hi)]);
    const long orow0 = rowbase + q0 + wid * 32;
    store_o(o, rli, F.O + orow0 * D + h * 64, D, F.PO + orow0 * 16, h, shm, wid, lane);
    asm volatile("s_waitcnt vmcnt(0) lgkmcnt(0)\n\ts_barrier" ::: "memory");
}

__device__ __forceinline__ void sb_unit(Frame& F, int b, int h, int qb, LAS unsigned char* shm) {
    const int wid = F.wave, lane = lane_id(), r32 = lane & 31, hi = lane >> 5;
    const long rowbase = (long)b * SEQ; const int q0 = qb * 256;
    const unsigned lds0 = (unsigned)(uintptr_t)shm;
    volatile LAS unsigned* flags = (volatile LAS unsigned*)(shm + LDS_FLAG);
    const bf16* ksrc = F.Y1 + (rowbase + lane) * NINP + C_KS + h * 64 + wid * 8;
    const bf16* vsrc = F.Y1 + (rowbase + 16 * (wid & 3) + (lane >> 2)) * NINP + C_VS + h * 64 + (wid >> 2) * 32 + (lane & 3) * 8;
    const unsigned kdst = lds0 + LDS_K + wid * 1024, vdst = lds0 + LDS_V + wid * 1024;
#define SB_DMA(t, sl) do { glds16(ksrc + (long)(t) * 64 * NINP, (unsigned)__builtin_amdgcn_readfirstlane(kdst + (sl) * KSLOT)); glds16(vsrc + (long)(t) * 64 * NINP, (unsigned)__builtin_amdgcn_readfirstlane(vdst + (sl) * VSLOT)); } while (0)
    const int NT = 4 * qb + 4, tl = 4 * qb + (wid >> 1);
    if (wid == 0 && lane < 3) flags[lane] = 0u;
    SB_DMA(NT - 1, 0); SB_DMA(NT - 2, 1);
    const bf16* Qw = F.Y1 + (rowbase + q0 + wid * 32 + r32) * NINP + C_QS + h * 64 + hi * 8;
    bf16x8 qr[4];
#pragma unroll
    for (int d0 = 0; d0 < 4; ++d0) qr[d0] = *(const GAS bf16x8*)(Qw + d0 * 16);
    float carry = 0.f; f32x16 o[2]; o[0] = f32x16{}; o[1] = f32x16{};
    const int qrel = (wid & 1) * 32 + r32;
    const lds_cptr shm3 = (lds_cptr)shm; const lds_cptr kp0 = shm3 + LDS_K + hi * 1024 + r32 * 16, vp0 = shm3 + LDS_V + ((lane >> 4) & 1) * 32 + (lane & 3) * 8 + (4 * hi + ((lane & 15) >> 2)) * 64;
    int sl = 0, sl2 = 2, f0 = 0;
    bool done = false;
    for (int i = 0; i < NT; ++i) {
        const int t = NT - 1 - i;
        if (i + 1 < NT) ATT_WAIT_BAR(2); else ATT_WAIT_BAR(0);
        if (i > 0) { const int fp = (f0 == 0) ? 2 : f0 - 1; if (flags[fp] == 0u) break; }
        { const int fn = (f0 == 2) ? 0 : f0 + 1; if (wid == 0 && lane == 0) flags[fn] = 0u; }
        if (i + 2 < NT) SB_DMA(t - 2, sl2);
        if (t <= tl && !done) {
            const lds_cptr kp = kp0 + sl * KSLOT;
            f32x16 z0 = f32x16{}, z1 = f32x16{};
#pragma unroll
            for (int d0 = 0; d0 < 4; ++d0) { const bf16x8 k0 = *(const __attribute__((address_space(3))) bf16x8*)(kp + d0 * 2048), k1 = *(const __attribute__((address_space(3))) bf16x8*)(kp + d0 * 2048 + 512);
                z0 = __builtin_amdgcn_mfma_f32_32x32x16_bf16(k0, qr[d0], z0, 0, 0, 0); z1 = __builtin_amdgcn_mfma_f32_32x32x16_bf16(k1, qr[d0], z1, 0, 0, 0); }
            f32x16 s0, s1;
#pragma unroll
            for (int r = 0; r < 16; ++r) { s0[r] = fmaxf(z0[r], 0.f) + __builtin_amdgcn_logf(1.0f + __builtin_amdgcn_exp2f(-fabsf(z0[r]))); s1[r] = fmaxf(z1[r], 0.f) + __builtin_amdgcn_logf(1.0f + __builtin_amdgcn_exp2f(-fabsf(z1[r]))); }
            const bool diag = (t == tl);
            if (diag) {
#pragma unroll
                for (int r = 0; r < 16; ++r) { const int kv = crow(r, hi); if (kv >= qrel) s0[r] = 0.f; if (kv + 32 >= qrel) s1[r] = 0.f; }
            }
            float own[8], part[8], R[8];
#pragma unroll
            for (int g = 0; g < 4; ++g) { own[g] = (s0[4 * g] + s0[4 * g + 1]) + (s0[4 * g + 2] + s0[4 * g + 3]); own[4 + g] = (s1[4 * g] + s1[4 * g + 1]) + (s1[4 * g + 2] + s1[4 * g + 3]); }
#pragma unroll
            for (int g = 0; g < 8; ++g) part[g] = swap32(own[g]);
            R[7] = 0.f;
#pragma unroll
            for (int g = 6; g >= 0; --g) R[g] = R[g + 1] + (own[g + 1] + part[g + 1]);
            const float total = R[0] + (own[0] + part[0]);
            f32x16 a0, a1;
#pragma unroll
            for (int g = 0; g < 4; ++g) {
                { const float base = carry - (R[g] + (hi == 0 ? part[g] : 0.f));
                  const float w3 = 0.f, w2 = s0[4 * g + 3], w1 = w2 + s0[4 * g + 2], w0 = w1 + s0[4 * g + 1];
                  a0[4 * g + 0] = __builtin_amdgcn_exp2f(z0[4 * g + 0] - s0[4 * g + 0] + (base - w0)); a0[4 * g + 1] = __builtin_amdgcn_exp2f(z0[4 * g + 1] - s0[4 * g + 1] + (base - w1));
                  a0[4 * g + 2] = __builtin_amdgcn_exp2f(z0[4 * g + 2] - s0[4 * g + 2] + (base - w2)); a0[4 * g + 3] = __builtin_amdgcn_exp2f(z0[4 * g + 3] - s0[4 * g + 3] + (base - w3)); }
                { const float base = carry - (R[4 + g] + (hi == 0 ? part[4 + g] : 0.f));
                  const float w3 = 0.f, w2 = s1[4 * g + 3], w1 = w2 + s1[4 * g + 2], w0 = w1 + s1[4 * g + 1];
                  a1[4 * g + 0] = __builtin_amdgcn_exp2f(z1[4 * g + 0] - s1[4 * g + 0] + (base - w0)); a1[4 * g + 1] = __builtin_amdgcn_exp2f(z1[4 * g + 1] - s1[4 * g + 1] + (base - w1));
                  a1[4 * g + 2] = __builtin_amdgcn_exp2f(z1[4 * g + 2] - s1[4 * g + 2] + (base - w2)); a1[4 * g + 3] = __builtin_amdgcn_exp2f(z1[4 * g + 3] - s1[4 * g + 3] + (base - w3)); }
            }
            if (diag) {
#pragma unroll
                for (int r = 0; r < 16; ++r) { const int kv = crow(r, hi); if (kv >= qrel) a0[r] = 0.f; if (kv + 32 >= qrel) a1[r] = 0.f; }
            }
            carry -= total;
            const bf16x8 pa[4] = {pack8(a0, 0), pack8(a0, 8), pack8(a1, 0), pack8(a1, 8)};
            pv(o, vp0 + sl * VSLOT, pa);
            done = __all(carry < SB_DONE);
        }
        if (!(t <= tl && done)) { if (lane == 0) flags[f0] = 1u; }
        sl = (sl == 2) ? 0 : sl + 1; sl2 = (sl2 == 2) ? 0 : sl2 + 1; f0 = (f0 == 2) ? 0 : f0 + 1;
    }
#undef SB_DMA
    float one[16];
#pragma unroll
    for (int r = 0; r < 16; ++r) one[r] = 1.0f;
    const long orow0 = rowbase + q0 + wid * 32;
    asm volatile("s_waitcnt vmcnt(0)" ::: "memory");
    store_o(o, one, F.O + orow0 * D + 512 + h * 64, D, F.PO + orow0 * 16, 8 + h, shm, wid, lane);
    asm volatile("s_waitcnt vmcnt(0) lgkmcnt(0)\n\ts_barrier" ::: "memory");
}
#undef ATT_WAIT_BAR
__device__ __forceinline__ void attn_phase(Frame& F, LAS unsigned char* shm) {
    const int bh = F.vcu >> 3, s = F.vcu & 7, b = bh >> 3, h = bh & 7;
    mla_unit(F, b, h, 15 - s, shm);
    mla_unit(F, b, h, s, shm);
    sb_unit(F, b, h, 15 - s, shm);
    sb_unit(F, b, h, s, shm);
}
}

enum { WK_IN = 0, WK_UQ, WK_UKV, WK_PLAIN, WK_GU };
__device__ __forceinline__ int p0_dst_row(int kind, int n) {
    if (kind == WK_IN) { if (n >= C_KR && n < C_QS) { const int i = n - C_KR; return C_KR + 2 * (i & 15) + (i >> 4); } return n; }
    if (kind == WK_UQ) { const int h = n / QKD, w = n % QKD; if (w >= NOPE) { const int i = w - NOPE; return h * QKD + NOPE + 2 * (i & 15) + (i >> 4); } return n; }
    if (kind == WK_UKV) { const int h = n >> 7, w = n & 127; return (w < 64) ? h * 64 + w : 512 + h * 64 + (w - 64); }
    if (kind == WK_GU) { const int nn = n & (DFF - 1); return (nn >> 7) * 256 + ((n >= DFF) ? 128 : 0) + (nn & 127); }
    return n;
}
__device__ __forceinline__ void p0_transpose_item(const float* W, int ldw, int nsrc, bf16* WT, int ldt, int k0, int n0, int kind, const float* gk, float sc, float sc_qs, int lane) {
    const int q = lane >> 4, c = lane & 15, n = n0 + 4 * c;
    if (n >= nsrc) return;
    const GAS float* src = (const GAS float*)W + (size_t)(k0 + 16 * q) * ldw + n;
    f32x4 v[16];
#pragma unroll
    for (int j = 0; j < 16; ++j) v[j] = __builtin_nontemporal_load((const GAS f32x4*)(src + (size_t)j * ldw));
    f32x4 g[4];
#pragma unroll
    for (int j = 0; j < 4; ++j) g[j] = gk ? *(const GAS f32x4*)(gk + k0 + 16 * q + 4 * j) * sc : (f32x4){sc, sc, sc, sc};
    const float s2 = (kind == WK_IN && n >= C_QS && n < C_KS) ? sc_qs : 1.0f;
#pragma unroll
    for (int i = 0; i < 4; ++i) {
        const int nd = p0_dst_row(kind, n + i);
        v4u o0, o1;
#pragma unroll
        for (int jj = 0; jj < 4; ++jj) { o0[jj] = pk2(v[2 * jj][i] * g[(2 * jj) >> 2][(2 * jj) & 3] * s2, v[2 * jj + 1][i] * g[(2 * jj + 1) >> 2][(2 * jj + 1) & 3] * s2);
            o1[jj] = pk2(v[8 + 2 * jj][i] * g[(8 + 2 * jj) >> 2][(8 + 2 * jj) & 3] * s2, v[8 + 2 * jj + 1][i] * g[(8 + 2 * jj + 1) >> 2][(8 + 2 * jj + 1) & 3] * s2); }
        GAS v4u* dst = (GAS v4u*)(WT + (size_t)nd * ldt + k0 + 16 * q);
        dst[0] = o0; dst[1] = o1;
    }
}
__device__ __forceinline__ void p0_weights(Frame& F) {
    const int gw = F.vcu * NWAVES + F.wave, NGW = F.G * NWAVES, lane = F.lane;
    constexpr int NB_IN = (NIN + 63) / 64;
    constexpr int I_IN = (D / 64) * NB_IN, I_UQ = (QLR / 64) * (HM * QKD / 64), I_UKV = (KVLR / 64) * (HM * 128 / 64), I_O = (D / 64) * (D / 64), I_PG = I_O, I_PP = (PLE / 64) * (D / 64);
    constexpr int I_GU1 = (D / 64) * (2 * DFF / 64), I_DN1 = (DFF / 64) * (D / 64);
    constexpr int I_SMALL = I_IN + I_UQ + I_UKV + I_O + I_PG + I_PP, NITEMS = I_SMALL + NE * (I_GU1 + I_DN1);
    bf16* WIN = (bf16*)(F.ws + WS_WIN); bf16* WUQ = (bf16*)(F.ws + WS_WUQ); bf16* WUKV = (bf16*)(F.ws + WS_WUKV); bf16* WO = (bf16*)(F.ws + WS_WO); bf16* WPG = (bf16*)(F.ws + WS_WPG); bf16* WPP = (bf16*)(F.ws + WS_WPP);
    bf16* WGU = (bf16*)(F.ws + WS_WGU); bf16* WDN = (bf16*)(F.ws + WS_WDN);
    for (int it = gw; it < NITEMS; it += NGW) {
        int r = it;
        if (r < I_IN) { const int kb = r / NB_IN, n0 = 64 * (r % NB_IN); p0_transpose_item(F.w_in, NIN, NIN, WIN, D, 64 * kb, n0, WK_IN, F.g_attn, 1.0f, QS_SCALE, lane); continue; } r -= I_IN;
        if (r < I_UQ) { const int nb = HM * QKD / 64, kb = r / nb, n0 = 64 * (r % nb); p0_transpose_item(F.w_uq, HM * QKD, HM * QKD, WUQ, QLR, 64 * kb, n0, WK_UQ, F.g_cq, Q_SCALE, 1.0f, lane); continue; } r -= I_UQ;
        if (r < I_UKV) { const int nb = HM * 128 / 64, kb = r / nb, n0 = 64 * (r % nb); p0_transpose_item(F.w_ukv, HM * 128, HM * 128, WUKV, KVLR, 64 * kb, n0, WK_UKV, F.g_ckv, 1.0f, 1.0f, lane); continue; } r -= I_UKV;
        if (r < I_O) { const int nb = D / 64, kb = r / nb, n0 = 64 * (r % nb); const int k0 = 64 * kb;
            p0_transpose_item(F.w_o, D, D, WO, D, k0, n0, WK_PLAIN, (k0 < 512) ? F.g_out_mla : F.g_out_sb - 512, 1.0f, 1.0f, lane); continue; } r -= I_O;
        if (r < I_PG) { const int nb = D / 64, kb = r / nb, n0 = 64 * (r % nb); p0_transpose_item(F.w_ple_gate, D, D, WPG, D, 64 * kb, n0, WK_PLAIN, F.g_ple, 1.0f, 1.0f, lane); continue; } r -= I_PG;
        if (r < I_PP) { const int nb = D / 64, kb = r / nb, n0 = 64 * (r % nb); p0_transpose_item(F.w_ple_proj, D, D, WPP, PLE, 64 * kb, n0, WK_PLAIN, nullptr, 1.0f, 1.0f, lane); continue; } r -= I_PP;
        const int e = r / (I_GU1 + I_DN1); r -= e * (I_GU1 + I_DN1);
        if (r < I_GU1) { const int nb = 2 * DFF / 64, kb = r / nb, n0 = 64 * (r % nb);
            p0_transpose_item(F.w_gu + (size_t)e * D * 2 * DFF, 2 * DFF, 2 * DFF, WGU + (size_t)e * 2 * DFF * D, D, 64 * kb, n0, WK_GU, F.g_moe, 1.0f, 1.0f, lane); continue; } r -= I_GU1;
        { const int nb = D / 64, kb = r / nb, n0 = 64 * (r % nb);
            p0_transpose_item(F.w_dn + (size_t)e * DFF * D, D, D, WDN + (size_t)e * D * DFF, DFF, 64 * kb, n0, WK_PLAIN, nullptr, 1.0f, 1.0f, lane); }
    }
    const int gt = blockIdx.x * NTHR + F.tid, NT = F.G * NTHR;
    for (int i = gt; i < (NINP - NIN) * D / 8; i += NT) ((GAS v4u*)(WIN + (size_t)NIN * D))[i] = (v4u){0u, 0u, 0u, 0u};
}

constexpr int N_PHASES = 13;
struct Args { const void* in[23]; float* out; unsigned char* ws; int ph_lo, ph_hi; };
__global__ void __launch_bounds__(NTHR, 2) mega_fwd(Args args) {
    extern __shared__ __attribute__((aligned(16))) unsigned char lds[];
    Frame F;
    F.lds = (LAS unsigned char*)lds;
    F.MISC = (volatile LAS unsigned*)(F.lds + MISC_OFF);
    F.tid = threadIdx.x; F.lane = F.tid & 63; F.wave = __builtin_amdgcn_readfirstlane(F.tid >> 6);
    F.G = gridDim.x; { const int bx = blockIdx.x; F.vcu = (F.G % 8 == 0) ? (bx % 8) * (F.G / 8) + bx / 8 : bx; }
    for (int u = F.tid; u < (LDS_BYTES - LDSCTL_OFF) / 4; u += NTHR) ((LAS unsigned*)(F.lds + LDSCTL_OFF))[u] = 0u;
    __syncthreads();
    if (F.tid == 0) { LAS unsigned long long* ap = (LAS unsigned long long*)(F.lds + L_ARGS);
#pragma unroll
        for (int i = 0; i < 23; ++i) ap[i] = (unsigned long long)args.in[i];
        ap[23] = (unsigned long long)args.out; ap[24] = (unsigned long long)args.ws; }
    __syncthreads();
    frame_refresh(F);
    const int lo = args.ph_lo, hi = args.ph_hi;
    const bool one = (hi - lo) > 1;
    XcdBarrier bar; bar.bar = (unsigned*)(F.ctl + CW_BAR); bar.x = 0; bar.st = nullptr;
    if (one) bar = xcd_barrier_post((unsigned*)(F.ctl + CW_BAR), F.MISC + 8);
#define IN(k) (frame_refresh(F), lo <= (k) && (k) < hi)
#define REP(k) _Pragma("unroll") for (int rep_ = 0; rep_ < ((((PROBE_DBL) >> (k)) & 1) ? 2 : 1); ++rep_)
#define SEAM(k) do { if (IN(k) && IN((k) + 1)) xcd_barrier(bar, F.wave); } while (0)
#define WIN ((bf16*)(F.ws + WS_WIN))
#define WUQ ((bf16*)(F.ws + WS_WUQ))
#define WUKV ((bf16*)(F.ws + WS_WUKV))
#define WO ((bf16*)(F.ws + WS_WO))
#define WPG ((bf16*)(F.ws + WS_WPG))
#define WPP ((bf16*)(F.ws + WS_WPP))
#define WGU ((bf16*)(F.ws + WS_WGU))
#define WDN ((bf16*)(F.ws + WS_WDN))
    LAS unsigned char* const ring = F.lds + RING_OFF;
    const volatile LAS int* const tsp = (const volatile LAS int*)(F.lds + L_TSTART);
    const int bid = (int)blockIdx.x;
    if (IN(0)) REP(0) { p0_prologue(F);
#if OPT_ROW
        r2_p0_rows(F); r2_p0_wrt(F);
#endif
#if OPT_P1 || OPT_P3 || OPT_P5 || OPT_P8 || OPT_P9 || OPT_P11
        p0_weights(F);
#endif
    } SEAM(0);
    if (IN(1)) REP(1) {
#if OPT_P1
        { pg8::Gemm g{F.XN, D, WIN, D, D}; pg8::StaticOrder S; S.init(T / 256, NINP / 256, F.G, bid); pg8::EpiInProj E{F.Y1, F.PA, F.COS, F.SIN};
          pg8::gemm_phase<pg8::EpiInProj, pg8::StaticOrder, true>(ring, F.wave, g, S, E); }
        { pg8::Gemm g{F.PBF, PLE, WPP, PLE, PLE}; pg8::StaticOrder S; S.init(T / 256, D / 256, F.G - 64, bid - 64); pg8::EpiStoreBf16 E{F.PROJ, D};
          pg8::gemm_phase<pg8::EpiStoreBf16, pg8::StaticOrder, true>(ring, F.wave, g, S, E); }
#else
        NE_InProj E{NIN}; naive_gemm(F, F.XN, D, T, E); NE_Proj E2{D}; naive_gemm(F, F.PBF, PLE, T, E2);
#endif
    } SEAM(1);
    if (IN(2)) {
#if !OPT_P1
        naive_rowssq(F);
#endif
    }
#if !OPT_P1
    SEAM(2);
#endif
    if (IN(3)) REP(3) {
#if OPT_P3
        { pg8::Gemm g{F.Y1 + C_CQ, NINP, WUQ, QLR, QLR}; pg8::StaticOrder S; S.init(T / 256, HM * QKD / 256, F.G, bid); pg8::EpiQ E{F.Q, F.PA, F.COS, F.SIN};
          pg8::gemm_phase<pg8::EpiQ, pg8::StaticOrder, false>(ring, F.wave, g, S, E); }
        { pg8::Gemm g{F.Y1 + C_CKV, NINP, WUKV, KVLR, KVLR}; pg8::StaticOrder S; S.init(T / 256, HM * 128 / 256, F.G, bid); pg8::EpiKV E{F.KN, F.VM, F.PA};
          pg8::gemm_phase<pg8::EpiKV, pg8::StaticOrder, false>(ring, F.wave, g, S, E); }
#else
        NE_Q E{HM * QKD}; naive_gemm(F, F.Y1 + C_CQ, NINP, T, E); NE_KV E2{HM * 128}; naive_gemm(F, F.Y1 + C_CKV, NINP, T, E2);
#endif
    } SEAM(3);
    if (IN(4)) REP(4) {
#if OPT_P4
        att::attn_phase(F, ring);
#else
        naive_attention(F);
#endif
    } SEAM(4);
    if (IN(5)) REP(5) {
#if OPT_P5
        pg8::Gemm g{F.O, D, WO, D, D}; pg8::StaticOrder S; S.init(T / 256, D / 256, F.G, bid); pg8::EpiWo E{F.x, F.H1, F.PO, (LAS float*)(F.lds + L_ROWS), (LAS float*)(F.lds + L_ROWS + 1024)};
        pg8::gemm_phase<pg8::EpiWo, pg8::StaticOrder, false>(ring, F.wave, g, S, E);
#else
        NE_Wo E{D}; naive_gemm(F, F.O, D, T, E);
#endif
    } SEAM(5);
#if OPT_ROW
    if (IN(6)) { r2_route(F); } SEAM(6);
    if (IN(7)) { r2_gather(F); } SEAM(7);
#else
    if (IN(6)) { p5a_route(F); } SEAM(6);
    if (IN(7)) { p5b_gather(F); } SEAM(7);
#endif
    if (IN(8)) REP(8) { if (!IN(7)) build_tstart(F);
#if OPT_P8
        pg8::Gemm g{F.XG, D, WGU, D, D}; pg8::GroupedOrder S; S.init(tsp[NE], 2 * DFF / 256, F.G, bid); S.ts = tsp; pg8::EpiGu E{F.ACT, F.b_gu};
        pg8::gemm_phase<pg8::EpiGu, pg8::GroupedOrder, true>(ring, F.wave, g, S, E);
#else
        NE_Gu E{DFF}; naive_gemm(F, F.XG, D, RPAD, E);
#endif
    } SEAM(8);
    if (IN(9)) REP(9) { if (!IN(7)) build_tstart(F);
#if OPT_P9
        pg8::Gemm g{F.ACT, DFF, WDN, DFF, DFF}; pg8::GroupedOrder S; S.init(tsp[NE], D / 256, F.G, bid); S.ts = tsp; pg8::EpiDn E{F.Yb, F.b_dn};
        pg8::gemm_phase<pg8::EpiDn, pg8::GroupedOrder, true>(ring, F.wave, g, S, E);
#else
        NE_Dn E{D}; naive_gemm(F, F.ACT, DFF, RPAD, E);
#endif
    } SEAM(9);
#if OPT_ROW
    if (IN(10)) { r2_combine(F); } SEAM(10);
#else
    if (IN(10)) { p8_combine(F); } SEAM(10);
#endif
    if (IN(11)) REP(11) {
#if OPT_P11
        pg8::Gemm g{F.XN, D, WPG, D, D}; pg8::StaticOrder S; S.init(T / 256, D / 256, F.G, bid); pg8::EpiGate E{F.H1, F.PROJ, F.out};
        pg8::gemm_phase<pg8::EpiGate, pg8::StaticOrder, false>(ring, F.wave, g, S, E);
#else
        NE_Gate E{D}; naive_gemm(F, F.XN, D, T, E);
#endif
    } SEAM(11);
#if OPT_ROW
    if (IN(12)) { r2_final(F); }
#else
    if (IN(12)) { p10_final(F); }
#endif
#undef IN
#undef SEAM
}

extern "C" void kernel_launch(void* const* d_in, const int* in_sizes, int n_in, void* d_out, int out_size, void* d_ws, size_t ws_size, hipStream_t stream) {
    static int grid = 0;
    if (grid == 0) {
        if (n_in != 23 || in_sizes[0] != T * D || out_size != T * D || ws_size < WS_END) { fprintf(stderr, "kernel_launch: unexpected shapes (n_in %d, in0 %d, out %d, ws %zu); nothing launched\n", n_in, n_in > 0 ? in_sizes[0] : -1, out_size, ws_size); grid = -1; return; }
        int dev = 0, cus = 0;
        if (hipGetDevice(&dev) != hipSuccess || hipDeviceGetAttribute(&cus, hipDeviceAttributeMultiprocessorCount, dev) != hipSuccess) { grid = -1; return; }
        if (hipFuncSetAttribute((const void*)mega_fwd, hipFuncAttributeMaxDynamicSharedMemorySize, LDS_BYTES) != hipSuccess) { fprintf(stderr, "kernel_launch: hipFuncSetAttribute failed\n"); grid = -1; return; }
        int per_cu = 0;
        if (hipOccupancyMaxActiveBlocksPerMultiprocessor(&per_cu, (const void*)mega_fwd, NTHR, LDS_BYTES) != hipSuccess || per_cu < 1) fprintf(stderr, "kernel_launch: occupancy query reports %d\n", per_cu);
        (void)hipGetLastError();
        grid = cus;
        if (grid != 256) fprintf(stderr, "kernel_launch: %d CUs (expected 256)\n", grid);
    }
    if (grid < 0) return;
    (void)hipMemsetAsync((char*)d_ws + WS_CTL, 0, CTL_ZERO_BYTES, stream);
    Args a{};
    for (int i = 0; i < 23; ++i) a.in[i] = d_in[i];
    a.out = (float*)d_out; a.ws = (unsigned char*)d_ws;
#if MK_ONE_LAUNCH
    a.ph_lo = 0; a.ph_hi = N_PHASES;
    hipLaunchKernelGGL(mega_fwd, dim3(grid), dim3(NTHR), LDS_BYTES, stream, a);
#else
    for (int ph = 0; ph < N_PHASES; ++ph) { a.ph_lo = ph; a.ph_hi = ph + 1; hipLaunchKernelGGL(mega_fwd, dim3(grid), dim3(NTHR), LDS_BYTES, stream, a); }
#endif
}
```

```cpp
#include <hip/hip_runtime.h>
#include <cstdio>
#include <cstdint>

#ifndef MK_ONE_LAUNCH
#define MK_ONE_LAUNCH 1
#endif
#ifndef PROBE_DBL
#define PROBE_DBL 0
#endif
#ifndef PROBE_XBAR
#define PROBE_XBAR 0
#endif
#define OPT_ROW 1
#define MOE_FP8 1
#define OPT_P1 1
#define OPT_P3 1
#define OPT_P4 1
#define OPT_P5 1
#define OPT_P8 1
#define OPT_P9 1
#define OPT_P11 1

constexpr int BATCH = 4, SEQ = 4096, T = BATCH * SEQ, D = 1024;
constexpr int NIN = 2208, NINP = 2304;
constexpr int QLR = 384, KVLR = 256, ROPE = 32, NOPE = 64, VDIM = 64, HM = 8, HS = 8, SBD = 64, QKD = NOPE + ROPE;
constexpr int C_CQ = 0, C_CKV = 384, C_KR = 640, C_QS = 672, C_KS = 1184, C_VS = 1696;
constexpr int NE = 32, TOPK = 4, DFF = 1024, PLE = 256;
constexpr int RPAD = T * TOPK + NE * 256;
constexpr float EPS = 1e-6f;
constexpr float LOG2E = 1.4426950408889634f;
constexpr float Q_SCALE = 0.10206207261596577f * LOG2E;
constexpr float QS_SCALE = 0.125f * LOG2E;
constexpr float SB_DONE = -200.0f;

constexpr int NWAVES = 8, NTHR = NWAVES * 64;

constexpr size_t MiB = 1u << 20;
constexpr size_t WS_CTL = 0, CTL_ZERO_BYTES = 1 * MiB;
constexpr size_t WS_WIN = 1 * MiB, WS_WUQ = 6 * MiB, WS_WUKV = 7 * MiB, WS_WO = 8 * MiB, WS_WPG = 10 * MiB, WS_WPP = 12 * MiB;
constexpr size_t WS_ROUTE = 13 * MiB, WS_CS = 14 * MiB;
constexpr size_t WS_WGU = 16 * MiB, WS_WDN = 144 * MiB, WS_XN = 208 * MiB, WS_Y1 = 240 * MiB, WS_Q = 312 * MiB, WS_KN = 336 * MiB, WS_VM = 352 * MiB;
constexpr size_t WS_O = 368 * MiB, WS_H1 = 400 * MiB, WS_PBF = 464 * MiB, WS_PROJ = 472 * MiB, WS_XG = 504 * MiB, WS_ACT = 648 * MiB, WS_PARTA = 792 * MiB, WS_PARTO = 793 * MiB, WS_END = 796 * MiB;
constexpr int CW_TMO = 0, CW_CODE = 1, CW_BAR = 4096, CW_CNT = 8192, CW_SSQ = 16384;
constexpr int SSQ_CQ = 0, SSQ_CKV = 1, SSQ_OM = 2, SSQ_OS = 3, SSQ_FIN = 4;
static_assert((CW_SSQ + 5 * T) * 4 <= (int)CTL_ZERO_BYTES, "ctl");

constexpr int RING_OFF = 0, RING_BYTES = 131072;
constexpr int LDSCTL_OFF = RING_BYTES, MISC_OFF = LDSCTL_OFF + 320;
constexpr int L_TSTART = LDSCTL_OFF + 1024;
constexpr int L_LCNT = LDSCTL_OFF + 1280;
constexpr int L_RSCR = LDSCTL_OFF + 2048;
constexpr int L_ARGS = LDSCTL_OFF + 6144;
constexpr int L_ROWS = LDSCTL_OFF + 4096;
constexpr int LDS_BYTES = 147456;

#define GAS __attribute__((address_space(1)))
#define LAS __attribute__((address_space(3)))
typedef unsigned short bf16;
typedef unsigned v4u __attribute__((ext_vector_type(4)));
typedef unsigned v2u __attribute__((ext_vector_type(2)));
typedef float f32x4 __attribute__((ext_vector_type(4)));
typedef GAS unsigned gu32;
#define RLX_AGENT __ATOMIC_RELAXED, __HIP_MEMORY_SCOPE_AGENT

__device__ __forceinline__ unsigned f2bf(float f) { unsigned u = __builtin_bit_cast(unsigned, f); return (u + 0x7fffu + ((u >> 16) & 1u)) >> 16; }
__device__ __forceinline__ unsigned pk2(float lo, float hi) { return f2bf(lo) | (f2bf(hi) << 16); }
__device__ __forceinline__ float bflo(unsigned w) { return __uint_as_float(w << 16); }
__device__ __forceinline__ float bfhi(unsigned w) { return __uint_as_float(w & 0xffff0000u); }
__device__ __forceinline__ float bf2f(bf16 v) { return __uint_as_float((unsigned)v << 16); }
__device__ __forceinline__ float wave_sum(float v) {
#pragma unroll
    for (int o = 1; o < 64; o <<= 1) v += __shfl_xor(v, o);
    return v;
}

__device__ __forceinline__ int lane_id() { int l; asm volatile("v_mbcnt_lo_u32_b32 %0, -1, 0\n\tv_mbcnt_hi_u32_b32 %0, -1, %0" : "=v"(l)); return l; }
#define XB_TMO      128
#define XB_XCNT(j)  (256  + 64 * (j))
#define XB_XSUB(j)  (1280 + 64 * (j))
#define XB_XGEN(j)  (2304 + 64 * (j))
#define XB_TOP      3328
#define XB_TOPGEN   3392
#define XCD_BAR_WORDS 3456
#define XB_SPIN_CAP (1u << 18)
__device__ __forceinline__ unsigned xb_ld(unsigned* p)              { return __hip_atomic_load(p, __ATOMIC_RELAXED, __HIP_MEMORY_SCOPE_AGENT); }
__device__ __forceinline__ unsigned xb_add(unsigned* p, unsigned v) { return __hip_atomic_fetch_add(p, v, __ATOMIC_RELAXED, __HIP_MEMORY_SCOPE_AGENT); }
__device__ __forceinline__ unsigned xb_xcc_id() { return (unsigned)__builtin_amdgcn_s_getreg((3 << 11) | 20) & 0xFu; }
#define XB_SPIN(cond, bar) do { unsigned _sp = 0; while (cond) { __builtin_amdgcn_s_sleep(1); \
    if ((++_sp & 255u) == 0u) { if (xb_ld(&(bar)[XB_TMO])) break; if (_sp > XB_SPIN_CAP) { atomicAdd(&(bar)[XB_TMO], 1u); break; } } } } while (0)
struct XcdBarrier { unsigned* bar; unsigned x; volatile LAS unsigned* st; };
__device__ __forceinline__ XcdBarrier xcd_barrier_post(unsigned* bar, volatile LAS unsigned* st) {
    XcdBarrier b; b.bar = bar; b.x = xb_xcc_id(); b.st = st;
    if (threadIdx.x == 0) (void)xb_add(&bar[XB_XCNT(b.x)], 1u);
    return b;
}
__device__ __forceinline__ void xcd_barrier_complete(unsigned* bar, unsigned x, unsigned& nloc, unsigned& nx) {
    const unsigned G = gridDim.x * gridDim.y * gridDim.z;
    unsigned sum, cnt, mine, sp = 0u;
    for (;;) {
        sum = 0u; cnt = 0u; mine = 0u;
#pragma unroll
        for (unsigned j = 0; j < 16; ++j) { const unsigned c = xb_ld(&bar[XB_XCNT(j)]); sum += c; cnt += (c > 0u) ? 1u : 0u; mine = (j == x) ? c : mine; }
        if (sum == G) break;
        __builtin_amdgcn_s_sleep(1);
        if ((++sp & 255u) == 0u) { if (xb_ld(&bar[XB_TMO])) break; if (sp > XB_SPIN_CAP) { atomicAdd(&bar[XB_TMO], 1u); break; } }
    }
    nloc = mine > 0u ? mine : 1u; nx = cnt > 0u ? cnt : 1u;
}
__device__ __forceinline__ void xcd_barrier(const XcdBarrier& b, int wave) {
    asm volatile("s_waitcnt vmcnt(0)" ::: "memory");
    __syncthreads();
    if (wave == 0 && lane_id() == 0) {
        unsigned* bar = b.bar;
        __builtin_amdgcn_s_waitcnt(0);
        unsigned nloc = b.st[0], nx = b.st[1];
        if (nloc == 0u) { xcd_barrier_complete(bar, b.x, nloc, nx); b.st[0] = nloc; b.st[1] = nx; }
        const unsigned old = xb_add(&bar[XB_XSUB(b.x)], 1u);
        const unsigned gen = old / nloc;
        if (old + 1u == (gen + 1u) * nloc) {
            __builtin_amdgcn_fence(__ATOMIC_RELEASE, "agent");
            asm volatile("s_waitcnt vmcnt(0)" ::: "memory");
            const unsigned og = xb_add(&bar[XB_TOP], 1u);
            const unsigned tg = og / nx;
            if (og + 1u == (tg + 1u) * nx) xb_add(&bar[XB_TOPGEN], 1u);
            else XB_SPIN(xb_ld(&bar[XB_TOPGEN]) == tg, bar);
            __builtin_amdgcn_fence(__ATOMIC_ACQUIRE, "agent");
            xb_add(&bar[XB_XGEN(b.x)], 1u);
            asm volatile("s_waitcnt vmcnt(0)" ::: "memory");
        } else {
            XB_SPIN(xb_ld(&bar[XB_XGEN(b.x)]) == gen, bar);
            __builtin_amdgcn_fence(__ATOMIC_ACQUIRE, "agent");
            asm volatile("s_waitcnt vmcnt(0)" ::: "memory");
        }
    }
    __syncthreads();
}

struct Frame {
    LAS unsigned char* lds;
    volatile LAS unsigned* MISC;
    gu32* ctl;
    float *PA, *PO;
    int tid, lane, wave, vcu, G; unsigned char* ws;
    const float *x, *p; const int* pos;
    const float *w_in, *g_attn, *g_cq, *w_uq, *g_ckv, *w_ukv, *g_out_mla, *g_out_sb, *w_o, *g_moe, *w_router, *b_router, *w_gu, *b_gu, *w_dn, *b_dn, *g_ple, *w_ple_gate, *w_ple_proj, *g_final;
    float* out;
    bf16 *XN, *Y1, *Q, *KN, *VM, *O, *PBF, *PROJ, *XG, *ACT, *Yb;
    float *H1, *COS, *SIN;
    int *topk_e, *lpos, *slot; float* gate;
};

__device__ __forceinline__ unsigned long long lds_arg(Frame& F, int i) {
    const LAS unsigned* ap = (const LAS unsigned*)(F.lds + L_ARGS) + 2 * i;
    const unsigned lo = __builtin_amdgcn_readfirstlane(ap[0]), hi = __builtin_amdgcn_readfirstlane(ap[1]);
    return ((unsigned long long)hi << 32) | lo;
}
__device__ __forceinline__ void frame_refresh(Frame& F) {
    asm volatile("" ::: "memory");
    F.lane = lane_id(); F.tid = F.wave * 64 + F.lane;
    F.x = (const float*)lds_arg(F, 0); F.p = (const float*)lds_arg(F, 1); F.pos = (const int*)lds_arg(F, 2);
    F.w_in = (const float*)lds_arg(F, 3); F.g_attn = (const float*)lds_arg(F, 4); F.g_cq = (const float*)lds_arg(F, 5); F.w_uq = (const float*)lds_arg(F, 6); F.g_ckv = (const float*)lds_arg(F, 7);
    F.w_ukv = (const float*)lds_arg(F, 8); F.g_out_mla = (const float*)lds_arg(F, 9); F.g_out_sb = (const float*)lds_arg(F, 10); F.w_o = (const float*)lds_arg(F, 11); F.g_moe = (const float*)lds_arg(F, 12);
    F.w_router = (const float*)lds_arg(F, 13); F.b_router = (const float*)lds_arg(F, 14); F.w_gu = (const float*)lds_arg(F, 15); F.b_gu = (const float*)lds_arg(F, 16); F.w_dn = (const float*)lds_arg(F, 17);
    F.b_dn = (const float*)lds_arg(F, 18); F.g_ple = (const float*)lds_arg(F, 19); F.w_ple_gate = (const float*)lds_arg(F, 20); F.w_ple_proj = (const float*)lds_arg(F, 21); F.g_final = (const float*)lds_arg(F, 22);
    F.out = (float*)lds_arg(F, 23);
    unsigned char* ws = (unsigned char*)lds_arg(F, 24); F.ws = ws;
    F.ctl = (gu32*)(ws + WS_CTL); F.PA = (float*)(ws + WS_PARTA); F.PO = (float*)(ws + WS_PARTO);
    F.XN = (bf16*)(ws + WS_XN); F.Y1 = (bf16*)(ws + WS_Y1); F.Q = (bf16*)(ws + WS_Q); F.KN = (bf16*)(ws + WS_KN); F.VM = (bf16*)(ws + WS_VM); F.O = (bf16*)(ws + WS_O);
    F.PBF = (bf16*)(ws + WS_PBF); F.PROJ = (bf16*)(ws + WS_PROJ); F.XG = (bf16*)(ws + WS_XG); F.ACT = (bf16*)(ws + WS_ACT); F.Yb = (bf16*)(ws + WS_XG);
    F.H1 = (float*)(ws + WS_H1); F.COS = (float*)(ws + WS_CS); F.SIN = (float*)(ws + WS_CS + MiB);
    F.topk_e = (int*)(ws + WS_ROUTE); F.gate = (float*)(ws + WS_ROUTE + 256 * 1024); F.lpos = (int*)(ws + WS_ROUTE + 512 * 1024); F.slot = (int*)(ws + WS_ROUTE + 768 * 1024);
}
__device__ __forceinline__ void p0_prologue(Frame& F) {
    const int gw = F.vcu * NWAVES + F.wave, NGW = F.G * NWAVES;
#if !OPT_ROW
    for (int m = gw; m < T; m += NGW) {
        const GAS f32x4* xr = (const GAS f32x4*)(F.x + (size_t)m * D) + F.lane;
        f32x4 v[4]; float s = 0.f;
#pragma unroll
        for (int j = 0; j < 4; ++j) { v[j] = xr[64 * j]; s += (v[j].x * v[j].x + v[j].y * v[j].y) + (v[j].z * v[j].z + v[j].w * v[j].w); }
        const float r = 1.0f / sqrtf(wave_sum(s) * (1.f / D) + EPS);
        GAS v2u* o8 = (GAS v2u*)(F.XN + (size_t)m * D) + F.lane;
#pragma unroll
        for (int j = 0; j < 4; ++j) { v2u w; w.x = pk2(v[j].x * r, v[j].y * r); w.y = pk2(v[j].z * r, v[j].w * r); o8[64 * j] = w; }
    }
#endif
    const int gt = blockIdx.x * NTHR + F.tid, NT = F.G * NTHR;
    for (int i = gt; i < T * PLE / 4; i += NT) { const f32x4 v = ((const GAS f32x4*)F.p)[i]; v2u w; w.x = pk2(v.x, v.y); w.y = pk2(v.z, v.w); ((GAS v2u*)F.PBF)[i] = w; }
    for (int i = gt; i < T * 16; i += NT) {
        const int m = i >> 4, f = i & 15;
        const float invf = exp2f(-(float)f * (13.287712379549449f / 16.0f));
        const float ang = (float)F.pos[m] * invf;
        double t = (double)ang * 0.15915494309189535; t -= __builtin_rint(t);
        const float fr = (float)t;
        F.COS[i] = __builtin_amdgcn_cosf(fr); F.SIN[i] = __builtin_amdgcn_sinf(fr);
    }
}

__device__ __forceinline__ float sum8(const float* p) { const f32x4 a = *(const GAS f32x4*)p, b = *(const GAS f32x4*)(p + 4); return ((a.x + a.y) + (a.z + a.w)) + ((b.x + b.y) + (b.z + b.w)); }
__device__ __forceinline__ void naive_rowssq(Frame& F) {
    const int gw = F.vcu * NWAVES + F.wave, NGW = F.G * NWAVES;
    for (int m = gw; m < T; m += NGW) {
        float sq = 0.f, skv = 0.f;
        for (int c = F.lane; c < C_KR; c += 64) { const float v = bf2f(F.Y1[(size_t)m * NINP + c]); if (c < C_CKV) sq += v * v; else skv += v * v; }
        sq = wave_sum(sq); skv = wave_sum(skv);
        if (F.lane < 16) F.PA[(size_t)m * 16 + F.lane] = (F.lane == 0) ? sq : (F.lane == 8) ? skv : 0.f;
    }
}
template <class Epi>
__device__ __forceinline__ void naive_gemm(Frame& F, const bf16* A, int lda, int M, const Epi& E) {
    const long total = (long)(M / 8) * E.nv;
    const long gt = (long)blockIdx.x * NTHR + F.tid, NT = (long)F.G * NTHR;
    for (long it = gt; it < total; it += NT) {
        const int j = (int)(it % E.nv), m0 = (int)(it / E.nv) * 8;
        const float* W; int ldw; const float *gk0, *gk1; int c0, c1, ka0, kb0, ka1, kb1;
        if (!E.setup(F, m0, j, W, ldw, gk0, gk1, c0, c1, ka0, kb0, ka1, kb1)) continue;
        float a0[8], a1[8];
#pragma unroll
        for (int r = 0; r < 8; ++r) { a0[r] = 0.f; a1[r] = 0.f; }
        const bf16* Ar = A + (size_t)m0 * lda;
        for (int k = ka0; k < kb0; k += 8) {
            v4u av[8];
#pragma unroll
            for (int r = 0; r < 8; ++r) av[r] = *(const GAS v4u*)(Ar + (size_t)r * lda + k);
#pragma unroll
            for (int kk = 0; kk < 8; ++kk) {
                const float w = W[(size_t)(k + kk) * ldw + c0] * (gk0 ? gk0[k + kk] : 1.f);
#pragma unroll
                for (int r = 0; r < 8; ++r) { const unsigned u = av[r][kk >> 1]; a0[r] += ((kk & 1) ? bfhi(u) : bflo(u)) * w; }
            }
        }
        for (int k = ka1; k < kb1; k += 8) {
            v4u av[8];
#pragma unroll
            for (int r = 0; r < 8; ++r) av[r] = *(const GAS v4u*)(Ar + (size_t)r * lda + k);
#pragma unroll
            for (int kk = 0; kk < 8; ++kk) {
                const float w = W[(size_t)(k + kk) * ldw + c1] * (gk1 ? gk1[k + kk] : 1.f);
#pragma unroll
                for (int r = 0; r < 8; ++r) { const unsigned u = av[r][kk >> 1]; a1[r] += ((kk & 1) ? bfhi(u) : bflo(u)) * w; }
            }
        }
        E.store(F, m0, j, a0, a1);
    }
}

__device__ __forceinline__ int expert_of_tile(Frame& F, int tile) {
    const volatile LAS int* ts = (const volatile LAS int*)(F.lds + L_TSTART);
    int e = -1;
    for (int i = 0; i < NE; ++i) if (tile >= ts[i] && tile < ts[i + 1]) e = i;
    return e;
}

struct NE_InProj {
    int nv;
    __device__ __forceinline__ bool setup(Frame& Fr, int m0, int j, const float*& W, int& ldw, const float*& gk0, const float*& gk1, int& c0, int& c1, int& ka0, int& kb0, int& ka1, int& kb1) const {
        if (j >= C_KR + 16 && j < C_QS) return false;
        W = Fr.w_in; ldw = NIN; gk0 = Fr.g_attn; gk1 = Fr.g_attn; c0 = j; c1 = j; ka0 = 0; kb0 = D; ka1 = 0; kb1 = 0;
        if (j >= C_KR && j < C_KR + 16) { c1 = j + 16; kb1 = D; }
        return true;
    }
    __device__ __forceinline__ void store(Frame& Fr, int m0, int j, const float* a0, const float* a1) const {
#pragma unroll
        for (int r = 0; r < 8; ++r) {
            const int m = m0 + r; bf16* y = Fr.Y1 + (size_t)m * NINP;
            if (j < C_KR) y[j] = (bf16)f2bf(a0[r]);
            else if (j < C_KR + 16) { const int i = j - C_KR; const float c = Fr.COS[m * 16 + i], s = Fr.SIN[m * 16 + i];
                y[C_KR + 2 * i] = (bf16)f2bf(a0[r] * c - a1[r] * s); y[C_KR + 2 * i + 1] = (bf16)f2bf(a1[r] * c + a0[r] * s); }
            else if (j < C_KS) y[j] = (bf16)f2bf(a0[r] * QS_SCALE);
            else y[j] = (bf16)f2bf(a0[r]);
        }
    }
};
struct NE_Q {
    int nv;
    __device__ __forceinline__ bool setup(Frame& Fr, int m0, int j, const float*& W, int& ldw, const float*& gk0, const float*& gk1, int& c0, int& c1, int& ka0, int& kb0, int& ka1, int& kb1) const {
        const int w = j % QKD; if (w >= NOPE + 16) return false;
        W = Fr.w_uq; ldw = HM * QKD; gk0 = Fr.g_cq; gk1 = Fr.g_cq; c0 = j; c1 = j; ka0 = 0; kb0 = QLR; ka1 = 0; kb1 = 0;
        if (w >= NOPE) { c1 = j + 16; kb1 = QLR; }
        return true;
    }
    __device__ __forceinline__ void store(Frame& Fr, int m0, int j, const float* a0, const float* a1) const {
        const int h = j / QKD, w = j % QKD;
#pragma unroll
        for (int r = 0; r < 8; ++r) {
            const int m = m0 + r; bf16* q = Fr.Q + (size_t)m * (HM * QKD) + h * QKD;
            const float rinv = 1.0f / sqrtf(sum8(Fr.PA + (size_t)m * 16) * (1.f / QLR) + EPS) * Q_SCALE;
            if (w < NOPE) q[w] = (bf16)f2bf(a0[r] * rinv);
            else { const int i = w - NOPE; const float c = Fr.COS[m * 16 + i], s = Fr.SIN[m * 16 + i]; const float x1 = a0[r] * rinv, x2 = a1[r] * rinv;
                q[NOPE + 2 * i] = (bf16)f2bf(x1 * c - x2 * s); q[NOPE + 2 * i + 1] = (bf16)f2bf(x2 * c + x1 * s); }
        }
    }
};
struct NE_KV {
    int nv;
    __device__ __forceinline__ bool setup(Frame& Fr, int m0, int j, const float*& W, int& ldw, const float*& gk0, const float*& gk1, int& c0, int& c1, int& ka0, int& kb0, int& ka1, int& kb1) const {
        W = Fr.w_ukv; ldw = HM * (NOPE + VDIM); gk0 = Fr.g_ckv; gk1 = nullptr; c0 = j; c1 = j; ka0 = 0; kb0 = KVLR; ka1 = 0; kb1 = 0; return true;
    }
    __device__ __forceinline__ void store(Frame& Fr, int m0, int j, const float* a0, const float* a1) const {
        const int h = j / 128, w = j % 128;
#pragma unroll
        for (int r = 0; r < 8; ++r) {
            const int m = m0 + r;
            const float rinv = 1.0f / sqrtf(sum8(Fr.PA + (size_t)m * 16 + 8) * (1.f / KVLR) + EPS);
            if (w < NOPE) Fr.KN[(size_t)m * 512 + h * 64 + w] = (bf16)f2bf(a0[r] * rinv);
            else Fr.VM[(size_t)m * 512 + h * 64 + (w - NOPE)] = (bf16)f2bf(a0[r] * rinv);
        }
    }
};
struct NE_Wo {
    int nv;
    __device__ __forceinline__ bool setup(Frame& Fr, int m0, int j, const float*& W, int& ldw, const float*& gk0, const float*& gk1, int& c0, int& c1, int& ka0, int& kb0, int& ka1, int& kb1) const {
        W = Fr.w_o; ldw = D; gk0 = Fr.g_out_mla; gk1 = Fr.g_out_sb - 512; c0 = j; c1 = j; ka0 = 0; kb0 = 512; ka1 = 512; kb1 = 1024; return true;
    }
    __device__ __forceinline__ void store(Frame& Fr, int m0, int j, const float* a0, const float* a1) const {
#pragma unroll
        for (int r = 0; r < 8; ++r) {
            const int m = m0 + r;
            const float rm = 1.0f / sqrtf(sum8(Fr.PO + (size_t)m * 16) * (1.f / 512) + EPS), rs = 1.0f / sqrtf(sum8(Fr.PO + (size_t)m * 16 + 8) * (1.f / 512) + EPS);
            Fr.H1[(size_t)m * D + j] = Fr.x[(size_t)m * D + j] + a0[r] * rm + a1[r] * rs;
        }
    }
};
struct NE_Gu {
    int nv;
    __device__ __forceinline__ bool setup(Frame& Fr, int m0, int j, const float*& W, int& ldw, const float*& gk0, const float*& gk1, int& c0, int& c1, int& ka0, int& kb0, int& ka1, int& kb1) const {
        const int e = expert_of_tile(Fr, m0 >> 8); if (e < 0) return false;
        W = Fr.w_gu + (size_t)e * D * 2 * DFF; ldw = 2 * DFF; gk0 = Fr.g_moe; gk1 = Fr.g_moe; c0 = j; c1 = DFF + j; ka0 = 0; kb0 = D; ka1 = 0; kb1 = D; return true;
    }
    __device__ __forceinline__ void store(Frame& Fr, int m0, int j, const float* a0, const float* a1) const {
        const int e = expert_of_tile(Fr, m0 >> 8);
        const float bg = Fr.b_gu[e * 2 * DFF + j], bl = Fr.b_gu[e * 2 * DFF + DFF + j];
#pragma unroll
        for (int r = 0; r < 8; ++r) {
            float g = fminf(a0[r] + bg, 7.0f), l = fminf(fmaxf(a1[r] + bl, -7.0f), 7.0f);
            const float act = g * (1.0f / (1.0f + __expf(-1.702f * g))) * (l + 1.0f);
            Fr.ACT[(size_t)(m0 + r) * DFF + j] = (bf16)f2bf(act);
        }
    }
};
struct NE_Dn {
    int nv;
    __device__ __forceinline__ bool setup(Frame& Fr, int m0, int j, const float*& W, int& ldw, const float*& gk0, const float*& gk1, int& c0, int& c1, int& ka0, int& kb0, int& ka1, int& kb1) const {
        const int e = expert_of_tile(Fr, m0 >> 8); if (e < 0) return false;
        W = Fr.w_dn + (size_t)e * DFF * D; ldw = D; gk0 = nullptr; gk1 = nullptr; c0 = j; c1 = j; ka0 = 0; kb0 = DFF; ka1 = 0; kb1 = 0; return true;
    }
    __device__ __forceinline__ void store(Frame& Fr, int m0, int j, const float* a0, const float* a1) const {
        const int e = expert_of_tile(Fr, m0 >> 8);
        const float b = Fr.b_dn[e * D + j];
#pragma unroll
        for (int r = 0; r < 8; ++r) Fr.Yb[(size_t)(m0 + r) * D + j] = (bf16)f2bf(a0[r] + b);
    }
};
struct NE_Proj {
    int nv;
    __device__ __forceinline__ bool setup(Frame& Fr, int m0, int j, const float*& W, int& ldw, const float*& gk0, const float*& gk1, int& c0, int& c1, int& ka0, int& kb0, int& ka1, int& kb1) const {
        W = Fr.w_ple_proj; ldw = D; gk0 = nullptr; gk1 = nullptr; c0 = j; c1 = j; ka0 = 0; kb0 = PLE; ka1 = 0; kb1 = 0; return true;
    }
    __device__ __forceinline__ void store(Frame& Fr, int m0, int j, const float* a0, const float* a1) const {
#pragma unroll
        for (int r = 0; r < 8; ++r) Fr.PROJ[(size_t)(m0 + r) * D + j] = (bf16)f2bf(a0[r]);
    }
};
struct NE_Gate {
    int nv;
    __device__ __forceinline__ bool setup(Frame& Fr, int m0, int j, const float*& W, int& ldw, const float*& gk0, const float*& gk1, int& c0, int& c1, int& ka0, int& kb0, int& ka1, int& kb1) const {
        W = Fr.w_ple_gate; ldw = D; gk0 = Fr.g_ple; gk1 = nullptr; c0 = j; c1 = j; ka0 = 0; kb0 = D; ka1 = 0; kb1 = 0; return true;
    }
    __device__ __forceinline__ void store(Frame& Fr, int m0, int j, const float* a0, const float* a1) const {
#pragma unroll
        for (int r = 0; r < 8; ++r) {
            const int m = m0 + r;
            const float h3 = Fr.H1[(size_t)m * D + j] + (1.0f / (1.0f + __expf(-a0[r]))) * bf2f(Fr.PROJ[(size_t)m * D + j]);
            Fr.out[(size_t)m * D + j] = h3;
        }
    }
};

__device__ __forceinline__ void naive_attention(Frame& F) {
    const long gt = (long)blockIdx.x * NTHR + F.tid, NT = (long)F.G * NTHR;
    const long total = 2L * T * 8;
    for (long it = gt; it < total; it += NT) {
        const int tl = (int)(it & 63); long r = it >> 6;
        const int h = (int)(r & 7); r >>= 3; const int grp = (int)(r & 1); r >>= 1; const int b = (int)(r & 3); r >>= 2; const int tc = (int)r;
        const int t = tc * 64 + tl; const int m = b * SEQ + t;
        float o[64];
#pragma unroll
        for (int d = 0; d < 64; ++d) o[d] = 0.f;
        if (grp == 0) {
            unsigned q[48];
            const GAS v4u* qp = (const GAS v4u*)(F.Q + (size_t)m * (HM * QKD) + h * QKD);
#pragma unroll
            for (int c = 0; c < 12; ++c) { const v4u v = qp[c]; q[4 * c] = v.x; q[4 * c + 1] = v.y; q[4 * c + 2] = v.z; q[4 * c + 3] = v.w; }
            float mx = -1e30f, l = 0.f;
            for (int s = 0; s <= t; ++s) {
                const int ms = b * SEQ + s;
                const GAS v4u* kp = (const GAS v4u*)(F.KN + (size_t)ms * 512 + h * 64);
                const GAS v4u* kr = (const GAS v4u*)(F.Y1 + (size_t)ms * NINP + C_KR);
                float sc = 0.f;
#pragma unroll
                for (int c = 0; c < 12; ++c) { const v4u kv = (c < 8) ? kp[c] : kr[c - 8];
#pragma unroll
                    for (int i = 0; i < 4; ++i) sc += bflo(q[4 * c + i]) * bflo(kv[i]) + bfhi(q[4 * c + i]) * bfhi(kv[i]); }
                const float mn = fmaxf(mx, sc), al = exp2f(mx - mn), pp = exp2f(sc - mn);
                l = l * al + pp; mx = mn;
                const GAS v4u* vp = (const GAS v4u*)(F.VM + (size_t)ms * 512 + h * 64);
#pragma unroll
                for (int c = 0; c < 8; ++c) { const v4u vv = vp[c];
#pragma unroll
                    for (int i = 0; i < 4; ++i) { o[8 * c + 2 * i] = o[8 * c + 2 * i] * al + pp * bflo(vv[i]); o[8 * c + 2 * i + 1] = o[8 * c + 2 * i + 1] * al + pp * bfhi(vv[i]); } }
            }
            const float rl = 1.0f / l;
#pragma unroll
            for (int d = 0; d < 64; ++d) o[d] *= rl;
        } else {
            unsigned q[32];
            const GAS v4u* qp = (const GAS v4u*)(F.Y1 + (size_t)m * NINP + C_QS + h * 64);
#pragma unroll
            for (int c = 0; c < 8; ++c) { const v4u v = qp[c]; q[4 * c] = v.x; q[4 * c + 1] = v.y; q[4 * c + 2] = v.z; q[4 * c + 3] = v.w; }
            float run = 0.f;
            for (int s = t - 1; s >= 0; --s) {
                if (run < SB_DONE) break;
                const int ms = b * SEQ + s;
                const GAS v4u* kp = (const GAS v4u*)(F.Y1 + (size_t)ms * NINP + C_KS + h * 64);
                float z = 0.f;
#pragma unroll
                for (int c = 0; c < 8; ++c) { const v4u kv = kp[c];
#pragma unroll
                    for (int i = 0; i < 4; ++i) z += bflo(q[4 * c + i]) * bflo(kv[i]) + bfhi(q[4 * c + i]) * bfhi(kv[i]); }
                const float sp = fmaxf(z, 0.f) + log2f(1.0f + exp2f(-fabsf(z)));
                const float a = exp2f(z - sp + run);
                run -= sp;
                const GAS v4u* vp = (const GAS v4u*)(F.Y1 + (size_t)ms * NINP + C_VS + h * 64);
#pragma unroll
                for (int c = 0; c < 8; ++c) { const v4u vv = vp[c];
#pragma unroll
                    for (int i = 0; i < 4; ++i) { o[8 * c + 2 * i] += a * bflo(vv[i]); o[8 * c + 2 * i + 1] += a * bfhi(vv[i]); } }
            }
        }
        float ss = 0.f;
        GAS v4u* op = (GAS v4u*)(F.O + (size_t)m * D + grp * 512 + h * 64);
#pragma unroll
        for (int c = 0; c < 8; ++c) { v4u w;
#pragma unroll
            for (int i = 0; i < 4; ++i) { w[i] = pk2(o[8 * c + 2 * i], o[8 * c + 2 * i + 1]); ss += o[8 * c + 2 * i] * o[8 * c + 2 * i] + o[8 * c + 2 * i + 1] * o[8 * c + 2 * i + 1]; }
            op[c] = w; }
        F.PO[(size_t)m * 16 + grp * 8 + h] = ss;
    }
}

__device__ __forceinline__ void p5a_route(Frame& F) {
    LAS float* WR = (LAS float*)(F.lds + RING_OFF);
    for (int i = F.tid; i < D * NE / 4; i += NTHR) {
        const f32x4 v = ((const GAS f32x4*)F.w_router)[i]; const int k = (4 * i) / NE, e0 = (4 * i) % NE; const float g = F.g_moe[k];
        WR[(e0 + 0) * D + k] = v.x * g; WR[(e0 + 1) * D + k] = v.y * g; WR[(e0 + 2) * D + k] = v.z * g; WR[(e0 + 3) * D + k] = v.w * g;
    }
    volatile LAS unsigned* lcnt = (volatile LAS unsigned*)(F.lds + L_LCNT);
    LAS unsigned* rscr = (LAS unsigned*)(F.lds + L_RSCR) + F.wave * 64;
    if (F.tid < 64) lcnt[F.tid] = 0u;
    __syncthreads();
    const int gw = F.vcu * NWAVES + F.wave, NGW = F.G * NWAVES;
    const int lane = F.lane;
    const int myexp = ((lane & 1) << 4) | ((lane & 2) << 2) | (lane & 4) | ((lane & 8) >> 2) | ((lane & 16) >> 4);
    const float mybias = F.b_router[myexp];
    int ri = 0;
    for (int m = gw; m < T; m += NGW, ++ri) {
        const GAS f32x4* xr = (const GAS f32x4*)(F.H1 + (size_t)m * D) + lane;
        f32x4 v[4]; float s = 0.f;
#pragma unroll
        for (int j = 0; j < 4; ++j) { v[j] = xr[64 * j]; s += (v[j].x * v[j].x + v[j].y * v[j].y) + (v[j].z * v[j].z + v[j].w * v[j].w); }
        const float r = 1.0f / sqrtf(wave_sum(s) * (1.f / D) + EPS);
        GAS v2u* o8 = (GAS v2u*)(F.XN + (size_t)m * D) + lane;
#pragma unroll
        for (int j = 0; j < 4; ++j) { v[j] = v[j] * r; v2u w; w.x = pk2(v[j].x, v[j].y); w.y = pk2(v[j].z, v[j].w); o8[64 * j] = w; }
        float a[32];
#pragma unroll
        for (int e = 0; e < 32; ++e) {
            float acc = 0.f;
#pragma unroll
            for (int j = 0; j < 4; ++j) { const f32x4 w = *(const LAS f32x4*)(WR + e * D + 256 * j + 4 * lane); acc += (v[j].x * w.x + v[j].y * w.y) + (v[j].z * w.z + v[j].w * w.w); }
            a[e] = acc;
            if ((e & 1) == 1) __builtin_amdgcn_sched_barrier(0);
        }
#pragma unroll
        for (int st = 0; st < 5; ++st) {
            const int hh = 16 >> st; const bool up = (lane >> st) & 1;
#pragma unroll
            for (int i = 0; i < hh; ++i) { const float send = up ? a[i] : a[hh + i]; const float recv = __shfl_xor(send, 1 << st); a[i] = (up ? a[hh + i] : a[i]) + recv; }
        }
        float val = a[0] + __shfl_xor(a[0], 32) + mybias;
        int tv_i[4]; float tv_v[4];
#pragma unroll
        for (int k = 0; k < 4; ++k) {
            float bv = val; int bi = myexp;
#pragma unroll
            for (int off = 1; off < 32; off <<= 1) { const float ov = __shfl_xor(bv, off); const int oi = __shfl_xor(bi, off); if (ov > bv || (ov == bv && oi < bi)) { bv = ov; bi = oi; } }
            tv_v[k] = bv; tv_i[k] = bi; if (myexp == bi) val = -INFINITY;
        }
        float g[4], gs = 0.f;
#pragma unroll
        for (int k = 0; k < 4; ++k) { g[k] = __expf(tv_v[k] - tv_v[0]); gs += g[k]; }
        const float rg = 1.0f / gs;
        if (lane == 0) {
#pragma unroll
            for (int k = 0; k < 4; ++k) {
                const unsigned pos = __hip_atomic_fetch_add((LAS unsigned*)(F.lds + L_LCNT) + tv_i[k], 1u, __ATOMIC_RELAXED, __HIP_MEMORY_SCOPE_WORKGROUP);
                F.topk_e[m * 4 + k] = tv_i[k]; F.gate[m * 4 + k] = g[k] * rg;
                if (ri < 8) { rscr[ri * 8 + k] = (unsigned)tv_i[k]; rscr[ri * 8 + 4 + k] = pos; }
            }
        }
    }
    __syncthreads();
    if (F.tid < 32) lcnt[32 + F.tid] = __hip_atomic_fetch_add((unsigned*)(F.ctl + CW_CNT) + F.tid, lcnt[F.tid], RLX_AGENT);
    __syncthreads();
    ri = 0;
    for (int m = gw; m < T; m += NGW, ++ri) if (lane < 4 && ri < 8) F.lpos[m * 4 + lane] = (int)(rscr[ri * 8 + 4 + lane] + lcnt[32 + rscr[ri * 8 + lane]]);
}
__device__ __forceinline__ void build_tstart(Frame& F) {
    volatile LAS int* ts = (volatile LAS int*)(F.lds + L_TSTART);
    if (F.tid == 0) { int acc = 0; for (int e = 0; e < NE; ++e) { ts[e] = acc; const unsigned c = __hip_atomic_load((unsigned*)(F.ctl + CW_CNT) + e, RLX_AGENT); acc += (int)((c + 255u) >> 8); } ts[NE] = acc; ts[40] = acc; }
    __syncthreads();
}
__device__ __forceinline__ void p5b_gather(Frame& F) {
    build_tstart(F);
    const volatile LAS int* ts = (const volatile LAS int*)(F.lds + L_TSTART);
    const int gw = F.vcu * NWAVES + F.wave, NGW = F.G * NWAVES;
    for (int m = gw; m < T; m += NGW) {
        const GAS v4u* src = (const GAS v4u*)(F.XN + (size_t)m * D) + F.lane;
        const v4u a = src[0], b = src[64];
#pragma unroll
        for (int k = 0; k < 4; ++k) {
            const int e = F.topk_e[m * 4 + k]; const int sl = ts[e] * 256 + F.lpos[m * 4 + k];
            if (F.lane == 0) F.slot[m * 4 + k] = sl;
            GAS v4u* dst = (GAS v4u*)(F.XG + (size_t)sl * D) + F.lane; dst[0] = a; dst[64] = b;
        }
    }
}
__device__ __forceinline__ void p8_combine(Frame& F) {
    const int gw = F.vcu * NWAVES + F.wave, NGW = F.G * NWAVES; const int lane = F.lane;
    for (int m = gw; m < T; m += NGW) {
        int sl[4]; float g[4];
#pragma unroll
        for (int k = 0; k < 4; ++k) { sl[k] = F.slot[m * 4 + k]; g[k] = F.gate[m * 4 + k]; }
        f32x4 h[2][2]; float s = 0.f;
#pragma unroll
        for (int j = 0; j < 2; ++j) {
            GAS f32x4* hp = (GAS f32x4*)(F.H1 + (size_t)m * D + 512 * j + 8 * lane);
            h[j][0] = hp[0]; h[j][1] = hp[1];
#pragma unroll
            for (int k = 0; k < 4; ++k) {
                const v4u y = *(const GAS v4u*)(F.Yb + (size_t)sl[k] * D + 512 * j + 8 * lane);
                h[j][0].x += g[k] * bflo(y.x); h[j][0].y += g[k] * bfhi(y.x); h[j][0].z += g[k] * bflo(y.y); h[j][0].w += g[k] * bfhi(y.y);
                h[j][1].x += g[k] * bflo(y.z); h[j][1].y += g[k] * bfhi(y.z); h[j][1].z += g[k] * bflo(y.w); h[j][1].w += g[k] * bfhi(y.w);
            }
            hp[0] = h[j][0]; hp[1] = h[j][1];
#pragma unroll
            for (int i = 0; i < 2; ++i) s += (h[j][i].x * h[j][i].x + h[j][i].y * h[j][i].y) + (h[j][i].z * h[j][i].z + h[j][i].w * h[j][i].w);
        }
        const float r = 1.0f / sqrtf(wave_sum(s) * (1.f / D) + EPS);
#pragma unroll
        for (int j = 0; j < 2; ++j) { v4u w; w.x = pk2(h[j][0].x * r, h[j][0].y * r); w.y = pk2(h[j][0].z * r, h[j][0].w * r); w.z = pk2(h[j][1].x * r, h[j][1].y * r); w.w = pk2(h[j][1].z * r, h[j][1].w * r);
            *(GAS v4u*)(F.XN + (size_t)m * D + 512 * j + 8 * lane) = w; }
    }
}
__device__ __forceinline__ void p10_final(Frame& F) {
    const int gw = F.vcu * NWAVES + F.wave, NGW = F.G * NWAVES; const int lane = F.lane;
    for (int m = gw; m < T; m += NGW) {
        GAS f32x4* op = (GAS f32x4*)(F.out + (size_t)m * D) + lane;
        f32x4 v[4]; float s = 0.f;
#pragma unroll
        for (int j = 0; j < 4; ++j) { v[j] = op[64 * j]; s += (v[j].x * v[j].x + v[j].y * v[j].y) + (v[j].z * v[j].z + v[j].w * v[j].w); }
        const float r = 1.0f / sqrtf(wave_sum(s) * (1.f / D) + EPS);
#pragma unroll
        for (int j = 0; j < 4; ++j) { const f32x4 g = ((const GAS f32x4*)F.g_final)[64 * j + lane]; op[64 * j] = v[j] * r * g; }
    }
}

constexpr size_t WS_WRT = 794 * MiB, WS_RINV = WS_WRT + 128 * 1024;
typedef float f32x16r __attribute__((ext_vector_type(16)));
namespace pg8 { __device__ __forceinline__ unsigned pk4_fp8(float a, float b, float c, float d); }
__device__ __forceinline__ float swap32f(float x) { const unsigned u = __float_as_uint(x); auto rr = __builtin_amdgcn_permlane32_swap(u, u, false, false); return __uint_as_float(rr[0] ^ rr[1] ^ u); }
__device__ __forceinline__ int swap32i(int x) { const unsigned u = (unsigned)x; auto rr = __builtin_amdgcn_permlane32_swap(u, u, false, false); return (int)(rr[0] ^ rr[1] ^ u); }
static_assert(T == 2048 * 8, "row phases: 8 consecutive rows per wave on a 256-workgroup grid");

__device__ __forceinline__ void r2_p0_rows(Frame& F) {
    const int gw = F.vcu * NWAVES + F.wave, lane = F.lane;
#pragma unroll 1
    for (int hf = 0; hf < 2; ++hf) {
        const int m0 = gw * 8 + hf * 4;
        f32x4 v[4][4]; float s[4];
#pragma unroll
        for (int r = 0; r < 4; ++r) { const GAS f32x4* xr = (const GAS f32x4*)(F.x + (size_t)(m0 + r) * D) + lane;
#pragma unroll
            for (int j = 0; j < 4; ++j) v[r][j] = __builtin_nontemporal_load(xr + 64 * j); }
#pragma unroll
        for (int r = 0; r < 4; ++r) { s[r] = 0.f;
#pragma unroll
            for (int j = 0; j < 4; ++j) s[r] += (v[r][j].x * v[r][j].x + v[r][j].y * v[r][j].y) + (v[r][j].z * v[r][j].z + v[r][j].w * v[r][j].w); }
#pragma unroll
        for (int o = 1; o < 64; o <<= 1) {
#pragma unroll
            for (int r = 0; r < 4; ++r) s[r] += __shfl_xor(s[r], o); }
#pragma unroll
        for (int r = 0; r < 4; ++r) { const float rr = 1.0f / sqrtf(s[r] * (1.f / D) + EPS); GAS v2u* o8 = (GAS v2u*)(F.XN + (size_t)(m0 + r) * D) + lane;
#pragma unroll
            for (int j = 0; j < 4; ++j) { v2u w; w.x = pk2(v[r][j].x * rr, v[r][j].y * rr); w.y = pk2(v[r][j].z * rr, v[r][j].w * rr); o8[64 * j] = w; } }
    }
}
__device__ __forceinline__ void r2_p0_wrt(Frame& F) {
    float* WRT = (float*)(F.ws + WS_WRT);
    const int gt = blockIdx.x * NTHR + F.tid, NT = F.G * NTHR;
    for (int i = gt; i < NE * D; i += NT) { const int e = i >> 10, k = i & (D - 1); WRT[i] = F.w_router[k * NE + e] * F.g_moe[k]; }
}
template <bool PROBE> __device__ __forceinline__ void r2_route(Frame& F) {
    int* const o_topk = PROBE ? (int*)(F.ws + WS_ACT) : F.topk_e; float* const o_gate = PROBE ? (float*)(F.ws + WS_ACT + MiB) : F.gate; int* const o_lpos = PROBE ? (int*)(F.ws + WS_ACT + 2 * MiB) : F.lpos;
    float* const o_rinv = PROBE ? (float*)(F.ws + WS_ACT + 3 * MiB) : (float*)(F.ws + WS_RINV); unsigned* const o_cnt = PROBE ? (unsigned*)(F.ws + WS_ACT + 4 * MiB) : (unsigned*)(F.ctl + CW_CNT);
    volatile LAS unsigned* lcnt = (volatile LAS unsigned*)(F.lds + L_LCNT);
    if (F.tid < 64) lcnt[F.tid] = 0u;
    __syncthreads();
    const int lane = F.lane, t = lane & 31, kh = lane >> 5;
    const bool active = F.wave < 2;
    int te[4]; unsigned tp[4]; int m = 0;
#pragma unroll
    for (int k = 0; k < 4; ++k) { te[k] = 0; tp[k] = 0u; }
    if (active) {
        const int tile = F.wave * 256 + F.vcu;
        m = tile * 32 + t;
        const GAS f32x4* hrow = (const GAS f32x4*)(F.H1 + (size_t)m * D + kh * 512);
        const GAS f32x4* wrow = (const GAS f32x4*)((const float*)(F.ws + WS_WRT) + (size_t)t * D + kh * 512);
        f32x16r acc = f32x16r{}; float ssq = 0.f;
#pragma unroll 8
        for (int i = 0; i < 128; ++i) {
            const f32x4 hv = hrow[i], wv = wrow[i];
            ssq += (hv.x * hv.x + hv.y * hv.y) + (hv.z * hv.z + hv.w * hv.w);
            acc = __builtin_amdgcn_mfma_f32_32x32x2f32(wv.x, hv.x, acc, 0, 0, 0); acc = __builtin_amdgcn_mfma_f32_32x32x2f32(wv.y, hv.y, acc, 0, 0, 0);
            acc = __builtin_amdgcn_mfma_f32_32x32x2f32(wv.z, hv.z, acc, 0, 0, 0); acc = __builtin_amdgcn_mfma_f32_32x32x2f32(wv.w, hv.w, acc, 0, 0, 0);
        }
        ssq += swap32f(ssq);
        const float rinv = 1.0f / sqrtf(ssq * (1.f / D) + EPS);
        if (kh == 0) o_rinv[m] = rinv;
        float lg[16];
#pragma unroll
        for (int g = 0; g < 4; ++g) { const f32x4 bv = *(const GAS f32x4*)(F.b_router + 8 * g + 4 * kh);
            lg[4 * g + 0] = acc[4 * g + 0] * rinv + bv.x; lg[4 * g + 1] = acc[4 * g + 1] * rinv + bv.y; lg[4 * g + 2] = acc[4 * g + 2] * rinv + bv.z; lg[4 * g + 3] = acc[4 * g + 3] * rinv + bv.w; }
        float A0, A1, A2, A3; int I0, I1, I2, I3;
        { float vv[4]; int ii[4];
#pragma unroll
          for (int k = 0; k < 4; ++k) { float bv = lg[0]; int bi = 0;
#pragma unroll
              for (int r = 1; r < 16; ++r) if (lg[r] > bv) { bv = lg[r]; bi = r; }
              vv[k] = bv; ii[k] = (bi & 3) + 8 * (bi >> 2) + 4 * kh;
#pragma unroll
              for (int r = 0; r < 16; ++r) if (r == bi) lg[r] = -INFINITY; }
          A0 = vv[0]; A1 = vv[1]; A2 = vv[2]; A3 = vv[3]; I0 = ii[0]; I1 = ii[1]; I2 = ii[2]; I3 = ii[3]; }
        float B0 = swap32f(A0), B1 = swap32f(A1), B2 = swap32f(A2), B3 = swap32f(A3); int J0 = swap32i(I0), J1 = swap32i(I1), J2 = swap32i(I2), J3 = swap32i(I3);
        float tv[4];
#pragma unroll
        for (int k = 0; k < 4; ++k) {
            const bool ta = (A0 > B0) || (A0 == B0 && I0 < J0);
            tv[k] = ta ? A0 : B0; te[k] = ta ? I0 : J0;
            if (ta) { A0 = A1; A1 = A2; A2 = A3; A3 = -INFINITY; I0 = I1; I1 = I2; I2 = I3; } else { B0 = B1; B1 = B2; B2 = B3; B3 = -INFINITY; J0 = J1; J1 = J2; J2 = J3; }
        }
        float g[4], gs = 0.f;
#pragma unroll
        for (int k = 0; k < 4; ++k) { g[k] = __expf(tv[k] - tv[0]); gs += g[k]; }
        const float rg = 1.0f / gs;
        if (kh == 0) {
#pragma unroll
            for (int k = 0; k < 4; ++k) { tp[k] = __hip_atomic_fetch_add((LAS unsigned*)(F.lds + L_LCNT) + te[k], 1u, __ATOMIC_RELAXED, __HIP_MEMORY_SCOPE_WORKGROUP);
                o_topk[m * 4 + k] = te[k]; o_gate[m * 4 + k] = g[k] * rg; }
        }
    }
    __syncthreads();
    if (F.tid < 32) lcnt[32 + F.tid] = __hip_atomic_fetch_add(o_cnt + F.tid, lcnt[F.tid], RLX_AGENT);
    __syncthreads();
    if (active && kh == 0) {
#pragma unroll
        for (int k = 0; k < 4; ++k) o_lpos[m * 4 + k] = (int)(tp[k] + lcnt[32 + te[k]]);
    }
}
__device__ __forceinline__ void r2_gather8(Frame& F) {
    build_tstart(F);
    const volatile LAS int* ts = (const volatile LAS int*)(F.lds + L_TSTART);
    const int gw = F.vcu * NWAVES + F.wave, lane = F.lane;
    int sl = 0;
    if (lane < 32) { const int mm = gw * 8 + (lane >> 2); const int e = F.topk_e[mm * 4 + (lane & 3)]; sl = ts[e] * 256 + F.lpos[mm * 4 + (lane & 3)]; F.slot[mm * 4 + (lane & 3)] = sl; }
    const float* RINV = (const float*)(F.ws + WS_RINV);
    unsigned char* XG8 = (unsigned char*)F.XG;
#pragma unroll 1
    for (int hf = 0; hf < 2; ++hf) {
        const int m0 = gw * 8 + hf * 4;
        f32x4 v[4][4];
#pragma unroll
        for (int r = 0; r < 4; ++r) { const GAS f32x4* hp = (const GAS f32x4*)(F.H1 + (size_t)(m0 + r) * D + 16 * lane);
#pragma unroll
            for (int j = 0; j < 4; ++j) v[r][j] = hp[j]; }
#pragma unroll
        for (int r = 0; r < 4; ++r) { const float rr = RINV[m0 + r] * 16.0f;
            v4u w;
#pragma unroll
            for (int j = 0; j < 4; ++j) w[j] = pg8::pk4_fp8(v[r][j].x * rr, v[r][j].y * rr, v[r][j].z * rr, v[r][j].w * rr);
#pragma unroll
            for (int k = 0; k < 4; ++k) { const int s = hf ? __builtin_amdgcn_readlane(sl, 16 + r * 4 + k) : __builtin_amdgcn_readlane(sl, r * 4 + k);
                *(GAS v4u*)(XG8 + (size_t)s * D + 16 * lane) = w; } }
    }
}
__device__ __forceinline__ void r2_gather(Frame& F) {
    build_tstart(F);
    const volatile LAS int* ts = (const volatile LAS int*)(F.lds + L_TSTART);
    const int gw = F.vcu * NWAVES + F.wave, lane = F.lane;
    int sl = 0;
    if (lane < 32) { const int mm = gw * 8 + (lane >> 2); const int e = F.topk_e[mm * 4 + (lane & 3)]; sl = ts[e] * 256 + F.lpos[mm * 4 + (lane & 3)]; F.slot[mm * 4 + (lane & 3)] = sl; }
    const float* RINV = (const float*)(F.ws + WS_RINV);
#pragma unroll 1
    for (int hf = 0; hf < 2; ++hf) {
        const int m0 = gw * 8 + hf * 4;
        f32x4 v[4][2][2];
#pragma unroll
        for (int r = 0; r < 4; ++r)
#pragma unroll
            for (int j = 0; j < 2; ++j) { const GAS f32x4* hp = (const GAS f32x4*)(F.H1 + (size_t)(m0 + r) * D + 512 * j + 8 * lane); v[r][j][0] = hp[0]; v[r][j][1] = hp[1]; }
#pragma unroll
        for (int r = 0; r < 4; ++r) { const float rr = RINV[m0 + r];
            v4u w[2];
#pragma unroll
            for (int j = 0; j < 2; ++j) { w[j].x = pk2(v[r][j][0].x * rr, v[r][j][0].y * rr); w[j].y = pk2(v[r][j][0].z * rr, v[r][j][0].w * rr); w[j].z = pk2(v[r][j][1].x * rr, v[r][j][1].y * rr); w[j].w = pk2(v[r][j][1].z * rr, v[r][j][1].w * rr); }
#pragma unroll
            for (int k = 0; k < 4; ++k) { const int s = hf ? __builtin_amdgcn_readlane(sl, 16 + r * 4 + k) : __builtin_amdgcn_readlane(sl, r * 4 + k);
                GAS v4u* dst = (GAS v4u*)(F.XG + (size_t)s * D + 8 * lane); dst[0] = w[0]; dst[64] = w[1]; } }
    }
}
template <bool PROBE> __device__ __forceinline__ void r2_combine(Frame& F) {
    float* const o_h = PROBE ? (float*)(F.ws + WS_ACT) : F.H1; bf16* const o_xn = PROBE ? (bf16*)(F.ws + WS_ACT + 64 * MiB) : F.XN;
    const int gw = F.vcu * NWAVES + F.wave, lane = F.lane;
    int sl = 0; float gt = 0.f;
    if (lane < 32) { const int mm = gw * 8 + (lane >> 2); sl = F.slot[mm * 4 + (lane & 3)]; gt = F.gate[mm * 4 + (lane & 3)]; }
#pragma unroll 1
    for (int q = 0; q < 4; ++q) {
        const int m0 = gw * 8 + q * 2;
        f32x4 h[2][2][2]; v4u y[2][4][2]; float g[2][4];
#pragma unroll
        for (int r = 0; r < 2; ++r) {
#pragma unroll
            for (int k = 0; k < 4; ++k) {
                int s; float gg;
                if (q == 0) { s = __builtin_amdgcn_readlane(sl, r * 4 + k); gg = __uint_as_float(__builtin_amdgcn_readlane(__float_as_uint(gt), r * 4 + k)); }
                else if (q == 1) { s = __builtin_amdgcn_readlane(sl, 8 + r * 4 + k); gg = __uint_as_float(__builtin_amdgcn_readlane(__float_as_uint(gt), 8 + r * 4 + k)); }
                else if (q == 2) { s = __builtin_amdgcn_readlane(sl, 16 + r * 4 + k); gg = __uint_as_float(__builtin_amdgcn_readlane(__float_as_uint(gt), 16 + r * 4 + k)); }
                else { s = __builtin_amdgcn_readlane(sl, 24 + r * 4 + k); gg = __uint_as_float(__builtin_amdgcn_readlane(__float_as_uint(gt), 24 + r * 4 + k)); }
                g[r][k] = gg;
#pragma unroll
                for (int j = 0; j < 2; ++j) y[r][k][j] = *(const GAS v4u*)(F.Yb + (size_t)s * D + 512 * j + 8 * lane);
            }
#pragma unroll
            for (int j = 0; j < 2; ++j) { const GAS f32x4* hp = (const GAS f32x4*)(F.H1 + (size_t)(m0 + r) * D + 512 * j + 8 * lane); h[r][j][0] = hp[0]; h[r][j][1] = hp[1]; }
        }
        float s2[2];
#pragma unroll
        for (int r = 0; r < 2; ++r) { s2[r] = 0.f;
#pragma unroll
            for (int j = 0; j < 2; ++j) {
#pragma unroll
                for (int k = 0; k < 4; ++k) { const v4u yy = y[r][k][j]; const float gg = g[r][k];
                    h[r][j][0].x += gg * bflo(yy.x); h[r][j][0].y += gg * bfhi(yy.x); h[r][j][0].z += gg * bflo(yy.y); h[r][j][0].w += gg * bfhi(yy.y);
                    h[r][j][1].x += gg * bflo(yy.z); h[r][j][1].y += gg * bfhi(yy.z); h[r][j][1].z += gg * bflo(yy.w); h[r][j][1].w += gg * bfhi(yy.w); }
                GAS f32x4* hp = (GAS f32x4*)(o_h + (size_t)(m0 + r) * D + 512 * j + 8 * lane); hp[0] = h[r][j][0]; hp[1] = h[r][j][1];
#pragma unroll
                for (int i = 0; i < 2; ++i) s2[r] += (h[r][j][i].x * h[r][j][i].x + h[r][j][i].y * h[r][j][i].y) + (h[r][j][i].z * h[r][j][i].z + h[r][j][i].w * h[r][j][i].w);
            } }
#pragma unroll
        for (int o = 1; o < 64; o <<= 1) { s2[0] += __shfl_xor(s2[0], o); s2[1] += __shfl_xor(s2[1], o); }
#pragma unroll
        for (int r = 0; r < 2; ++r) { const float rr = 1.0f / sqrtf(s2[r] * (1.f / D) + EPS);
#pragma unroll
            for (int j = 0; j < 2; ++j) { v4u w; w.x = pk2(h[r][j][0].x * rr, h[r][j][0].y * rr); w.y = pk2(h[r][j][0].z * rr, h[r][j][0].w * rr); w.z = pk2(h[r][j][1].x * rr, h[r][j][1].y * rr); w.w = pk2(h[r][j][1].z * rr, h[r][j][1].w * rr);
                *(GAS v4u*)(o_xn + (size_t)(m0 + r) * D + 512 * j + 8 * lane) = w; } }
    }
}
template <bool PROBE> __device__ __forceinline__ void r2_final(Frame& F) {
    float* const o_out = PROBE ? (float*)(F.ws + WS_ACT) : F.out;
    const int gw = F.vcu * NWAVES + F.wave, lane = F.lane;
    f32x4 gf[4];
#pragma unroll
    for (int j = 0; j < 4; ++j) gf[j] = ((const GAS f32x4*)F.g_final)[64 * j + lane];
#pragma unroll 1
    for (int hf = 0; hf < 2; ++hf) {
        const int m0 = gw * 8 + hf * 4;
        f32x4 v[4][4]; float s[4];
#pragma unroll
        for (int r = 0; r < 4; ++r) { const GAS f32x4* xr = (const GAS f32x4*)(F.out + (size_t)(m0 + r) * D) + lane;
#pragma unroll
            for (int j = 0; j < 4; ++j) v[r][j] = xr[64 * j]; }
#pragma unroll
        for (int r = 0; r < 4; ++r) { s[r] = 0.f;
#pragma unroll
            for (int j = 0; j < 4; ++j) s[r] += (v[r][j].x * v[r][j].x + v[r][j].y * v[r][j].y) + (v[r][j].z * v[r][j].z + v[r][j].w * v[r][j].w); }
#pragma unroll
        for (int o = 1; o < 64; o <<= 1) {
#pragma unroll
            for (int r = 0; r < 4; ++r) s[r] += __shfl_xor(s[r], o); }
#pragma unroll
        for (int r = 0; r < 4; ++r) { const float rr = 1.0f / sqrtf(s[r] * (1.f / D) + EPS); GAS f32x4* xr = (GAS f32x4*)(o_out + (size_t)(m0 + r) * D) + lane;
#pragma unroll
            for (int j = 0; j < 4; ++j) xr[64 * j] = v[r][j] * rr * gf[j]; }
    }
}

namespace pg8 {
#define PG8_LAS __attribute__((address_space(3)))
typedef unsigned short bf16_t;
typedef short bf16x8 __attribute__((ext_vector_type(8)));
typedef unsigned u32x4 __attribute__((ext_vector_type(4)));
typedef unsigned u32x2 __attribute__((ext_vector_type(2)));
constexpr int BM = 256, BK = 64, HALF = 128, HTB = HALF * BK * 2, STAGE_BYTES = 8 * HTB, NXCD = 8, WGM = 8;
__host__ __device__ __forceinline__ int lds_byte(int r, int c) { const int st = (r >> 4) * 2 + (c >> 5), rr = r & 15, cc = c & 31, ob = rr * 64 + cc * 2; return st * 1024 + (ob ^ (((ob >> 9) & 1) << 5)); }
__host__ __device__ __forceinline__ void stage_rc(int b, int& R, int& C) { const int st = b / 1024, sb = b % 1024, swz = sb ^ (((sb >> 9) & 1) << 5); R = (st >> 1) * 16 + swz / 64; C = (st & 1) * 32 + (swz % 64) / 2; }
__host__ __device__ __forceinline__ int perm32(int rho) { const int n = rho >> 4, i = rho & 15; return 8 * (i >> 2) + 4 * n + (i & 3); }

typedef int v8i32 __attribute__((ext_vector_type(8)));
struct Frag2 { bf16x8 k[2]; };
struct Frag8 { v8i32 v; };
template <int ESZ> struct FragT;
template <> struct FragT<2> { struct A { Frag2 f[4]; }; struct B { Frag2 f[2]; }; };
template <> struct FragT<1> { struct A { Frag8 f[4]; }; struct B { Frag8 f[2]; }; };
__device__ __forceinline__ void ld_frag(Frag2& d, const PG8_LAS unsigned char* p) { d.k[0] = *(const PG8_LAS bf16x8*)p; d.k[1] = *(const PG8_LAS bf16x8*)(p + 1024); }
__device__ __forceinline__ void ld_frag(Frag8& d, const PG8_LAS unsigned char* p) { const u32x4 x = *(const PG8_LAS u32x4*)p, y = *(const PG8_LAS u32x4*)(p + 1024); d.v = (v8i32){(int)x.x, (int)x.y, (int)x.z, (int)x.w, (int)y.x, (int)y.y, (int)y.z, (int)y.w}; }
__device__ __forceinline__ f32x4 mma_frag(const Frag2& b, const Frag2& a, f32x4 c) { c = __builtin_amdgcn_mfma_f32_16x16x32_bf16(b.k[0], a.k[0], c, 0, 0, 0); return __builtin_amdgcn_mfma_f32_16x16x32_bf16(b.k[1], a.k[1], c, 0, 0, 0); }
__device__ __forceinline__ f32x4 mma_frag(const Frag8& b, const Frag8& a, f32x4 c) { const int sc = 0x7f7f7f7f;
    asm volatile("v_mfma_scale_f32_16x16x128_f8f6f4 %0, %1, %2, %0, %3, %3 op_sel_hi:[0,0,0]" : "+v"(c) : "v"(b.v), "v"(a.v), "v"(sc)); return c; }
__device__ __forceinline__ void glds16s(const void* sbase, unsigned voff, unsigned lds_dst) {
    const unsigned long long b = (unsigned long long)sbase; const unsigned blo = __builtin_amdgcn_readfirstlane((unsigned)b), bhi = __builtin_amdgcn_readfirstlane((unsigned)(b >> 32));
    const unsigned long long sb = ((unsigned long long)bhi << 32) | blo; const unsigned ld = __builtin_amdgcn_readfirstlane(lds_dst); unsigned keep;
    asm volatile("s_mov_b32 %0, m0\n\ts_mov_b32 m0, %3\n\ts_nop 0\n\tglobal_load_lds_dwordx4 %1, %2\n\ts_mov_b32 m0, %0" : "=&s"(keep) : "v"(voff), "s"(sb), "s"(ld) : "memory"); }
struct Unit { int pm, pn, pb, e; };
struct Gemm { const bf16_t* A; int lda; const bf16_t* Bt; int ldb; int K; };

struct StaticOrder {
    int nM, nN, nwg, G, c;
    __device__ void init(int nM_, int nN_, int G_, int c_) { nM = nM_; nN = nN_; nwg = nM * nN; G = G_; c = c_; }
    __device__ bool next(int i, Unit& u) const {
        const long L = (long)i * G + c; if (c < 0 || L >= nwg) return false;
        int wgid = (int)L; { const int q = nwg / NXCD, r = nwg % NXCD, xcd = wgid % NXCD, off = wgid / NXCD; wgid = (xcd < r ? xcd * (q + 1) : r * (q + 1) + (xcd - r) * q) + off; }
        const int nig = WGM * nN, gid = wgid / nig, fm = gid * WGM, gsz = (nM - fm) < WGM ? (nM - fm) : WGM;
        u.pm = fm + ((wgid % nig) % gsz); u.pn = (wgid % nig) / gsz; u.pb = u.pn; u.e = 0; return true;
    }
};
struct GroupedOrder : StaticOrder {
    const volatile PG8_LAS int* ts;
    __device__ bool next(int i, Unit& u) const {
        if (!StaticOrder::next(i, u)) return false;
        int e = 0;
        for (int j = 1; j < 32; ++j) e = (u.pm >= ts[j]) ? j : e;
        e = __builtin_amdgcn_readfirstlane(e);
        u.e = e; u.pb = e * nN + u.pn; return true;
    }
};

__device__ __forceinline__ unsigned cvt_pk_bf16(float lo, float hi) { unsigned r; asm volatile("v_cvt_pk_bf16_f32 %0, %1, %2" : "=v"(r) : "v"(lo), "v"(hi)); return r; }
__device__ __forceinline__ u32x4 pack8(const f32x4& a, const f32x4& b) { u32x4 w; w.x = cvt_pk_bf16(a[0], a[1]); w.y = cvt_pk_bf16(a[2], a[3]); w.z = cvt_pk_bf16(b[0], b[1]); w.w = cvt_pk_bf16(b[2], b[3]); return w; }
__device__ __forceinline__ float psum8(const float* p) { const f32x4 a = *(const f32x4*)p, b = *(const f32x4*)(p + 4); return ((a[0] + a[1]) + (a[2] + a[3])) + ((b[0] + b[1]) + (b[2] + b[3])); }
__device__ __forceinline__ void rope8(f32x4& a, f32x4& b, const f32x4& c, const f32x4& s) {
    const float a0 = a[0] * c[0] - a[1] * s[0], a1 = a[1] * c[0] + a[0] * s[0], a2 = a[2] * c[1] - a[3] * s[1], a3 = a[3] * c[1] + a[2] * s[1];
    const float b0 = b[0] * c[2] - b[1] * s[2], b1 = b[1] * c[2] + b[0] * s[2], b2 = b[2] * c[3] - b[3] * s[3], b3 = b[3] * c[3] + b[2] * s[3];
    a = (f32x4){a0, a1, a2, a3}; b = (f32x4){b0, b1, b2, b3};
}
struct EpiStoreBf16 {
    static constexpr bool PERM = true, AFTER_DRAIN = false, HAS_MID = false;
    bf16_t* O; int ldc;
    __device__ __forceinline__ void operator()(const f32x4 (&acc)[2][2][4][2], const Unit& u, int wr, int wc, int fr, int fq) const {
        const int row0 = u.pm * BM + wr * 64 + fr, col0 = u.pn * BM + wc * 32 + 8 * fq;
#pragma unroll
        for (int ai = 0; ai < 2; ++ai)
#pragma unroll
            for (int m = 0; m < 4; ++m) { bf16_t* rowp = O + (size_t)(row0 + ai * HALF + m * 16) * ldc + col0;
#pragma unroll
                for (int bj = 0; bj < 2; ++bj) *(u32x4*)(rowp + bj * HALF) = pack8(acc[ai][bj][m][0], acc[ai][bj][m][1]); }
    }
};
struct EpiInProj {
    static constexpr bool PERM = true, AFTER_DRAIN = false, HAS_MID = false;
    bf16_t* Y; float* PA; const float* COS; const float* SIN;
    __device__ __forceinline__ void operator()(const f32x4 (&acc)[2][2][4][2], const Unit& u, int wr, int wc, int fr, int fq) const {
        const int row0 = u.pm * BM + wr * 64 + fr, col0 = u.pn * BM + wc * 32 + 8 * fq;
        const bool rope = (u.pn == 2 && wc == 0);
#pragma unroll
        for (int ai = 0; ai < 2; ++ai)
#pragma unroll
            for (int m = 0; m < 4; ++m) {
                const int row = row0 + ai * HALF + m * 16;
                f32x4 v00 = acc[ai][0][m][0], v01 = acc[ai][0][m][1], v10 = acc[ai][1][m][0], v11 = acc[ai][1][m][1];
                if (u.pn <= 2) {
                    float s0 = ((v00[0] * v00[0] + v00[1] * v00[1]) + (v00[2] * v00[2] + v00[3] * v00[3])) + ((v01[0] * v01[0] + v01[1] * v01[1]) + (v01[2] * v01[2] + v01[3] * v01[3]));
                    float s1 = ((v10[0] * v10[0] + v10[1] * v10[1]) + (v10[2] * v10[2] + v10[3] * v10[3])) + ((v11[0] * v11[0] + v11[1] * v11[1]) + (v11[2] * v11[2] + v11[3] * v11[3]));
                    s0 += __shfl_xor(s0, 16); s0 += __shfl_xor(s0, 32); s1 += __shfl_xor(s1, 16); s1 += __shfl_xor(s1, 32);
                    if (fq == 0) {
                        if (u.pn == 0) PA[(size_t)row * 16 + wc] = s0 + s1;
                        else if (u.pn == 1) { PA[(size_t)row * 16 + 4 + wc] = s0; PA[(size_t)row * 16 + 8 + wc] = s1; }
                        else PA[(size_t)row * 16 + 12 + wc] = s0;
                    }
                }
                if (rope) { const f32x4 c = *(const f32x4*)(COS + (size_t)row * 16 + 4 * fq), s = *(const f32x4*)(SIN + (size_t)row * 16 + 4 * fq); rope8(v10, v11, c, s); }
                bf16_t* rowp = Y + (size_t)row * NINP + col0;
                *(u32x4*)(rowp) = pack8(v00, v01); *(u32x4*)(rowp + HALF) = pack8(v10, v11);
            }
    }
};
struct EpiQ {
    static constexpr bool PERM = true, AFTER_DRAIN = false, HAS_MID = false;
    bf16_t* Q; const float* PA; const float* COS; const float* SIN;
    __device__ __forceinline__ void operator()(const f32x4 (&acc)[2][2][4][2], const Unit& u, int wr, int wc, int fr, int fq) const {
        const int row0 = u.pm * BM + wr * 64 + fr, col0 = u.pn * BM + wc * 32 + 8 * fq;
        const bool rope0 = ((8 * u.pn + wc) % 3) == 2, rope1 = ((8 * u.pn + 4 + wc) % 3) == 2;
#pragma unroll
        for (int ai = 0; ai < 2; ++ai)
#pragma unroll
            for (int m = 0; m < 4; ++m) {
                const int row = row0 + ai * HALF + m * 16;
                const float rinv = 1.0f / sqrtf(psum8(PA + (size_t)row * 16) * (1.f / QLR) + EPS);
                f32x4 v00 = acc[ai][0][m][0] * rinv, v01 = acc[ai][0][m][1] * rinv, v10 = acc[ai][1][m][0] * rinv, v11 = acc[ai][1][m][1] * rinv;
                if (rope0 || rope1) { const f32x4 c = *(const f32x4*)(COS + (size_t)row * 16 + 4 * fq), s = *(const f32x4*)(SIN + (size_t)row * 16 + 4 * fq);
                    if (rope0) rope8(v00, v01, c, s); if (rope1) rope8(v10, v11, c, s); }
                bf16_t* rowp = Q + (size_t)row * (HM * QKD) + col0;
                *(u32x4*)(rowp) = pack8(v00, v01); *(u32x4*)(rowp + HALF) = pack8(v10, v11);
                asm volatile("" ::: "memory");
            }
    }
};
struct EpiKV {
    static constexpr bool PERM = true, AFTER_DRAIN = false, HAS_MID = false;
    bf16_t* KNp; bf16_t* VMp; const float* PA;
    __device__ __forceinline__ void operator()(const f32x4 (&acc)[2][2][4][2], const Unit& u, int wr, int wc, int fr, int fq) const {
        const int row0 = u.pm * BM + wr * 64 + fr, col0 = (u.pn & 1) * BM + wc * 32 + 8 * fq;
        bf16_t* base = (u.pn < 2) ? KNp : VMp;
#pragma unroll
        for (int ai = 0; ai < 2; ++ai)
#pragma unroll
            for (int m = 0; m < 4; ++m) {
                const int row = row0 + ai * HALF + m * 16;
                const float rinv = 1.0f / sqrtf(psum8(PA + (size_t)row * 16 + 8) * (1.f / KVLR) + EPS);
                bf16_t* rowp = base + (size_t)row * 512 + col0;
#pragma unroll
                for (int bj = 0; bj < 2; ++bj) *(u32x4*)(rowp + bj * HALF) = pack8(acc[ai][bj][m][0] * rinv, acc[ai][bj][m][1] * rinv);
                asm volatile("" ::: "memory");
            }
    }
};
struct EpiWo {
    static constexpr bool PERM = false, AFTER_DRAIN = false, HAS_MID = true;
    const float* X; float* H; const float* PO; PG8_LAS float* RAT; PG8_LAS float* RS;
    __device__ __forceinline__ void begin(const Unit& u, int t) const {
        if (t < 256) { const int row = u.pm * BM + t;
            const float rm = 1.0f / sqrtf(psum8(PO + (size_t)row * 16) * (1.f / 512) + EPS), rs = 1.0f / sqrtf(psum8(PO + (size_t)row * 16 + 8) * (1.f / 512) + EPS);
            RAT[t] = rm / rs; RS[t] = rs; }
    }
    __device__ __forceinline__ void mid(f32x4 (&acc)[2][2][4][2], int wr, int fr) const {
#pragma unroll
        for (int ai = 0; ai < 2; ++ai)
#pragma unroll
            for (int m = 0; m < 4; ++m) { const float f = RAT[ai * HALF + wr * 64 + m * 16 + fr];
#pragma unroll
                for (int bj = 0; bj < 2; ++bj)
#pragma unroll
                    for (int n = 0; n < 2; ++n) acc[ai][bj][m][n] = acc[ai][bj][m][n] * f; }
    }
    __device__ __forceinline__ void operator()(const f32x4 (&acc)[2][2][4][2], const Unit& u, int wr, int wc, int fr, int fq) const {
        const int row0 = u.pm * BM + wr * 64 + fr, col0 = u.pn * BM + wc * 32 + 4 * fq;
#pragma unroll
        for (int ai = 0; ai < 2; ++ai)
#pragma unroll
            for (int m = 0; m < 4; ++m) { const float rs = RS[ai * HALF + wr * 64 + m * 16 + fr]; const size_t off = (size_t)(row0 + ai * HALF + m * 16) * D + col0;
#pragma unroll
                for (int bj = 0; bj < 2; ++bj)
#pragma unroll
                    for (int n = 0; n < 2; ++n) { const f32x4 xv = *(const f32x4*)(X + off + bj * HALF + n * 16); *(f32x4*)(H + off + bj * HALF + n * 16) = xv + acc[ai][bj][m][n] * rs; } }
    }
};
struct EpiGu {
    static constexpr bool PERM = true, AFTER_DRAIN = false, HAS_MID = false;
    bf16_t* ACTp; const float* bgu;
    __device__ __forceinline__ void operator()(const f32x4 (&acc)[2][2][4][2], const Unit& u, int wr, int wc, int fr, int fq) const {
        const int row0 = u.pm * BM + wr * 64 + fr, cg = u.pn * HALF + wc * 32 + 8 * fq;
        const float* bb = bgu + (size_t)u.e * (2 * DFF) + cg;
        const f32x4 bg0 = *(const f32x4*)(bb), bg1 = *(const f32x4*)(bb + 4), bl0 = *(const f32x4*)(bb + DFF), bl1 = *(const f32x4*)(bb + DFF + 4);
#pragma unroll
        for (int ai = 0; ai < 2; ++ai)
#pragma unroll
            for (int m = 0; m < 4; ++m) {
                f32x4 o[2];
#pragma unroll
                for (int n = 0; n < 2; ++n) { const f32x4 g4 = acc[ai][0][m][n] + (n ? bg1 : bg0), l4 = acc[ai][1][m][n] + (n ? bl1 : bl0);
#pragma unroll
                    for (int i = 0; i < 4; ++i) { const float g = fminf(g4[i], 7.0f), l = fminf(fmaxf(l4[i], -7.0f), 7.0f);
                        o[n][i] = g * __builtin_amdgcn_rcpf(1.0f + __builtin_amdgcn_exp2f(-1.702f * LOG2E * g)) * (l + 1.0f); } }
                *(u32x4*)(ACTp + (size_t)(row0 + ai * HALF + m * 16) * DFF + cg) = pack8(o[0], o[1]);
            }
    }
};
struct EpiDn {
    static constexpr bool PERM = true, AFTER_DRAIN = false, HAS_MID = false;
    bf16_t* Yp; const float* bdn;
    __device__ __forceinline__ void operator()(const f32x4 (&acc)[2][2][4][2], const Unit& u, int wr, int wc, int fr, int fq) const {
        const int row0 = u.pm * BM + wr * 64 + fr, col0 = u.pn * BM + wc * 32 + 8 * fq;
        const float* bb = bdn + (size_t)u.e * D + col0;
        f32x4 bv[2][2];
#pragma unroll
        for (int bj = 0; bj < 2; ++bj)
#pragma unroll
            for (int n = 0; n < 2; ++n) bv[bj][n] = *(const f32x4*)(bb + bj * HALF + 4 * n);
#pragma unroll
        for (int ai = 0; ai < 2; ++ai)
#pragma unroll
            for (int m = 0; m < 4; ++m) { bf16_t* rowp = Yp + (size_t)(row0 + ai * HALF + m * 16) * D + col0;
#pragma unroll
                for (int bj = 0; bj < 2; ++bj) *(u32x4*)(rowp + bj * HALF) = pack8(acc[ai][bj][m][0] + bv[bj][0], acc[ai][bj][m][1] + bv[bj][1]); }
    }
};
__device__ __forceinline__ unsigned pk4_fp8(float a, float b, float c, float d) { int w = 0; w = __builtin_amdgcn_cvt_pk_fp8_f32(a, b, w, false); w = __builtin_amdgcn_cvt_pk_fp8_f32(c, d, w, true); return (unsigned)w; }
struct EpiGu8 {
    static constexpr bool PERM = true, AFTER_DRAIN = false, HAS_MID = false;
    unsigned char* ACTp; const float* bgu;
    __device__ __forceinline__ void operator()(const f32x4 (&acc)[2][2][4][2], const Unit& u, int wr, int wc, int fr, int fq) const {
        const int row0 = u.pm * BM + wr * 64 + fr, cg = u.pn * HALF + wc * 32 + 8 * fq;
        const float* bb = bgu + (size_t)u.e * (2 * DFF) + cg;
        const f32x4 bg0 = *(const f32x4*)(bb), bg1 = *(const f32x4*)(bb + 4), bl0 = *(const f32x4*)(bb + DFF), bl1 = *(const f32x4*)(bb + DFF + 4);
#pragma unroll
        for (int ai = 0; ai < 2; ++ai)
#pragma unroll
            for (int m = 0; m < 4; ++m) {
                f32x4 o[2];
#pragma unroll
                for (int n = 0; n < 2; ++n) { const f32x4 g4 = acc[ai][0][m][n] * (1.0f / 512.0f) + (n ? bg1 : bg0), l4 = acc[ai][1][m][n] * (1.0f / 512.0f) + (n ? bl1 : bl0);
#pragma unroll
                    for (int i = 0; i < 4; ++i) { const float g = fminf(g4[i], 7.0f), l = fminf(fmaxf(l4[i], -7.0f), 7.0f);
                        o[n][i] = 4.0f * g * __builtin_amdgcn_rcpf(1.0f + __builtin_amdgcn_exp2f(-1.702f * LOG2E * g)) * (l + 1.0f); } }
                u32x2 w; w.x = pk4_fp8(o[0][0], o[0][1], o[0][2], o[0][3]); w.y = pk4_fp8(o[1][0], o[1][1], o[1][2], o[1][3]);
                *(u32x2*)(ACTp + (size_t)(row0 + ai * HALF + m * 16) * DFF + cg) = w;
            }
    }
};
struct EpiDn8 {
    static constexpr bool PERM = true, AFTER_DRAIN = false, HAS_MID = false;
    bf16_t* Yp; const float* bdn;
    __device__ __forceinline__ void operator()(const f32x4 (&acc)[2][2][4][2], const Unit& u, int wr, int wc, int fr, int fq) const {
        const int row0 = u.pm * BM + wr * 64 + fr, col0 = u.pn * BM + wc * 32 + 8 * fq;
        const float* bb = bdn + (size_t)u.e * D + col0;
        f32x4 bv[2][2];
#pragma unroll
        for (int bj = 0; bj < 2; ++bj)
#pragma unroll
            for (int n = 0; n < 2; ++n) bv[bj][n] = *(const f32x4*)(bb + bj * HALF + 4 * n);
#pragma unroll
        for (int ai = 0; ai < 2; ++ai)
#pragma unroll
            for (int m = 0; m < 4; ++m) { bf16_t* rowp = Yp + (size_t)(row0 + ai * HALF + m * 16) * D + col0;
#pragma unroll
                for (int bj = 0; bj < 2; ++bj) *(u32x4*)(rowp + bj * HALF) = pack8(acc[ai][bj][m][0] * (1.0f / 128.0f) + bv[bj][0], acc[ai][bj][m][1] * (1.0f / 128.0f) + bv[bj][1]); }
    }
};
struct EpiGate {
    static constexpr bool PERM = false, AFTER_DRAIN = false, HAS_MID = false;
    const float* H; const bf16_t* PR; float* OUT;
    __device__ __forceinline__ void operator()(const f32x4 (&acc)[2][2][4][2], const Unit& u, int wr, int wc, int fr, int fq) const {
        const int row0 = u.pm * BM + wr * 64 + fr, col0 = u.pn * BM + wc * 32 + 4 * fq;
#pragma unroll
        for (int ai = 0; ai < 2; ++ai)
#pragma unroll
            for (int m = 0; m < 4; ++m) { const size_t off = (size_t)(row0 + ai * HALF + m * 16) * D + col0;
#pragma unroll
                for (int bj = 0; bj < 2; ++bj)
#pragma unroll
                    for (int n = 0; n < 2; ++n) { const size_t o2 = off + bj * HALF + n * 16; const f32x4 hv = *(const f32x4*)(H + o2); const u32x2 pw = *(const u32x2*)(PR + o2); const f32x4 a = acc[ai][bj][m][n];
                        f32x4 r;
                        r[0] = hv[0] + __builtin_amdgcn_rcpf(1.0f + __builtin_amdgcn_exp2f(-LOG2E * a[0])) * __uint_as_float(pw.x << 16);
                        r[1] = hv[1] + __builtin_amdgcn_rcpf(1.0f + __builtin_amdgcn_exp2f(-LOG2E * a[1])) * __uint_as_float(pw.x & 0xffff0000u);
                        r[2] = hv[2] + __builtin_amdgcn_rcpf(1.0f + __builtin_amdgcn_exp2f(-LOG2E * a[2])) * __uint_as_float(pw.y << 16);
                        r[3] = hv[3] + __builtin_amdgcn_rcpf(1.0f + __builtin_amdgcn_exp2f(-LOG2E * a[3])) * __uint_as_float(pw.y & 0xffff0000u);
                        *(f32x4*)(OUT + o2) = r; } }
    }
};

template <class Epi, class Sched, bool ALIGN_EPI, int ESZ = 2>
__device__ __forceinline__ void gemm_phase(PG8_LAS unsigned char* lds, int wave_id, const Gemm g, const Sched& S, const Epi& E) {
    const int wid = wave_id, lane = lane_id(), tid = wid * 64 + lane, wr = wid >> 2, wc = wid & 3, fr = lane & 15, fq = lane >> 4;
    const int K = g.K, nt = K * ESZ / (BK * 2);
    unsigned voffA[2], voffB[2];
#pragma unroll
    for (int i = 0; i < 2; ++i) { int R, C; stage_rc(tid * 16 + i * 8192, R, C); const int Rb = Epi::PERM ? ((R & ~31) + perm32(R & 31)) : R;
        voffA[i] = (unsigned)(R * g.lda * ESZ + C * 2); voffB[i] = (unsigned)(Rb * g.ldb * ESZ + C * 2); }
    const size_t kstep = (size_t)(BK * 2);
    const size_t hstepA = (size_t)HALF * g.lda * ESZ, hstepB = (size_t)HALF * g.ldb * ESZ;
    const size_t tstepA = 2 * hstepA, tstepB = 2 * hstepB;
    const unsigned ldsw = (unsigned)wid * 1024u, lds0 = (unsigned)(uintptr_t)lds;
    const int aoff = lds_byte(wr * 64 + fr, fq * 8), boff = lds_byte(wc * 32 + fr, fq * 8);
#define PG8_SA(b, h) (((b) * 2 + (h)) * HTB)
#define PG8_SB(b, h) ((4 + (b) * 2 + (h)) * HTB)
#define PG8_STAGE(bufoff, gbase, voff) do { _Pragma("unroll") for (int _i = 0; _i < 2; ++_i) glds16s((gbase), (voff)[_i], lds0 + (unsigned)(bufoff) + ldsw + _i * 8192u); } while (0)
#define PG8_LDA(dst, b, h) do { _Pragma("unroll") for (int m = 0; m < 4; ++m) ld_frag(dst.f[m], lds + PG8_SA(b, h) + aoff + m * 2048); } while (0)
#define PG8_LDB(dst, b, h) do { _Pragma("unroll") for (int n = 0; n < 2; ++n) ld_frag(dst.f[n], lds + PG8_SB(b, h) + boff + n * 2048); } while (0)
#define PG8_MMA(ai, bj, At, Bt) do { __builtin_amdgcn_s_setprio(1); _Pragma("unroll") for (int m = 0; m < 4; ++m) _Pragma("unroll") for (int n = 0; n < 2; ++n) { \
        acc[ai][bj][m][n] = mma_frag(Bt.f[n], At.f[m], acc[ai][bj][m][n]); } \
        __builtin_amdgcn_s_setprio(0); } while (0)
#define PG8_WAIT_V(n) asm volatile("s_waitcnt vmcnt(" #n ")" ::: "memory")
#define PG8_WAIT_L(n) asm volatile("s_waitcnt lgkmcnt(" #n ")" ::: "memory")
#define PG8_BAR __builtin_amdgcn_s_barrier()
#define PG8_SCHED __builtin_amdgcn_sched_barrier(0)
    Unit cur, nxt; int ui = 0;
    if (!S.next(0, cur)) return;
    f32x4 acc[2][2][4][2];
#pragma unroll
    for (int a = 0; a < 2; ++a)
#pragma unroll
        for (int b = 0; b < 2; ++b)
#pragma unroll
            for (int m = 0; m < 4; ++m)
#pragma unroll
                for (int n = 0; n < 2; ++n) acc[a][b][m][n] = (f32x4){0.f, 0.f, 0.f, 0.f};
    typename FragT<ESZ>::A At; typename FragT<ESZ>::B B0, B1;
    const char* cA = (const char*)g.A + (size_t)cur.pm * tstepA; const char* cB = (const char*)g.Bt + (size_t)cur.pb * tstepB;
    if constexpr (Epi::HAS_MID) E.begin(cur, tid);
    PG8_STAGE(PG8_SB(0, 0), cB, voffB); PG8_STAGE(PG8_SB(0, 1), cB + hstepB, voffB); PG8_STAGE(PG8_SA(0, 0), cA, voffA); PG8_STAGE(PG8_SA(0, 1), cA + hstepA, voffA);
    if (wr == 1) PG8_BAR;
    PG8_WAIT_V(2); PG8_BAR;
    PG8_STAGE(PG8_SB(1, 0), cB + kstep, voffB); PG8_STAGE(PG8_SA(1, 0), cA + kstep, voffA); PG8_STAGE(PG8_SB(1, 1), cB + hstepB + kstep, voffB);
    PG8_WAIT_V(6); PG8_BAR;
    for (;;) {
        const bool has_next = S.next(ui + 1, nxt);
        const char* nA = has_next ? (const char*)g.A + (size_t)nxt.pm * tstepA : cA; const char* nB = has_next ? (const char*)g.Bt + (size_t)nxt.pb * tstepB : cB;
#pragma unroll 1
        for (int t = 0; t < nt; t += 2) {
            const bool last = (t == nt - 2);
            const char* a1 = cA + (size_t)(t + 1) * kstep;
            const char* a2 = last ? nA : cA + (size_t)(t + 2) * kstep; const char* b2 = last ? nB : cB + (size_t)(t + 2) * kstep;
            const char* a3 = a2 + kstep; const char* b3 = b2 + kstep;
            if constexpr (Epi::HAS_MID) { if (t == nt / 2) E.mid(acc, wr, lane_id() & 15); }
            PG8_LDB(B0, 0, 0); PG8_LDB(B1, 0, 1); PG8_SCHED; PG8_LDA(At, 0, 0); PG8_STAGE(PG8_SA(1, 1), a1 + hstepA, voffA);
            PG8_WAIT_V(8); PG8_WAIT_L(0); PG8_BAR; PG8_MMA(0, 0, At, B0); PG8_MMA(0, 1, At, B1); PG8_BAR; PG8_SCHED;
            PG8_LDA(At, 0, 1); PG8_STAGE(PG8_SB(0, 0), b2, voffB); PG8_STAGE(PG8_SB(0, 1), b2 + hstepB, voffB); PG8_STAGE(PG8_SA(0, 0), a2, voffA);
            PG8_WAIT_V(8); PG8_WAIT_L(0); PG8_BAR; PG8_MMA(1, 0, At, B0); PG8_MMA(1, 1, At, B1); PG8_BAR; PG8_SCHED;
            PG8_LDB(B0, 1, 0); PG8_LDB(B1, 1, 1); PG8_SCHED; PG8_LDA(At, 1, 0); PG8_STAGE(PG8_SA(0, 1), a2 + hstepA, voffA);
            PG8_WAIT_V(8); PG8_WAIT_L(0); PG8_BAR; PG8_MMA(0, 0, At, B0); PG8_MMA(0, 1, At, B1); PG8_BAR; PG8_SCHED;
            PG8_LDA(At, 1, 1); PG8_STAGE(PG8_SB(1, 0), b3, voffB); PG8_STAGE(PG8_SB(1, 1), b3 + hstepB, voffB); PG8_STAGE(PG8_SA(1, 0), a3, voffA);
            PG8_WAIT_V(8); PG8_WAIT_L(0); PG8_BAR; PG8_MMA(1, 0, At, B0); PG8_MMA(1, 1, At, B1); PG8_BAR; PG8_SCHED;
        }
        if constexpr (ALIGN_EPI) { if (wr == 0) PG8_BAR; }
        if constexpr (ESZ == 1) asm volatile("s_nop 15\n\ts_nop 15" ::: "memory");
        { const int l2 = lane_id();
          E(acc, cur, wr, wc, l2 & 15, l2 >> 4); }
        if (!has_next) break;
#pragma unroll
        for (int a = 0; a < 2; ++a)
#pragma unroll
            for (int b = 0; b < 2; ++b)
#pragma unroll
                for (int m = 0; m < 4; ++m)
#pragma unroll
                    for (int n = 0; n < 2; ++n) acc[a][b][m][n] = (f32x4){0.f, 0.f, 0.f, 0.f};
        cur = nxt; cA = nA; cB = nB; ++ui;
        if constexpr (ALIGN_EPI) { if (wr == 1) PG8_BAR; }
    }
    PG8_WAIT_V(0);
    if constexpr (!ALIGN_EPI) { if (wr == 0) PG8_BAR; }
    PG8_BAR;
#undef PG8_SA
#undef PG8_SB
#undef PG8_STAGE
#undef PG8_LDA
#undef PG8_LDB
#undef PG8_MMA
#undef PG8_WAIT_V
#undef PG8_WAIT_L
#undef PG8_BAR
#undef PG8_SCHED
}
}

namespace att {
typedef short bf16x8 __attribute__((ext_vector_type(8)));
typedef short s16x4 __attribute__((ext_vector_type(4)));
typedef float f32x16 __attribute__((ext_vector_type(16)));
typedef __attribute__((address_space(3))) const char* lds_cptr;
constexpr int KSLOT = 12288, VSLOT = 8192, LDS_K = 0, LDS_V = 3 * KSLOT, LDS_WS = LDS_V + 3 * VSLOT, LDS_OST = LDS_WS + 8 * 256, LDS_FLAG = LDS_OST + 8 * 4096, ATT_BYTES = LDS_FLAG + 64;
static_assert(ATT_BYTES <= RING_BYTES, "attention LDS");
__device__ __forceinline__ int crow(int r, int hi) { return (r & 3) + 8 * (r >> 2) + 4 * hi; }
__device__ __forceinline__ void glds16(const void* gsrc, unsigned lds_dst) { unsigned keep;
    asm volatile("s_mov_b32 %0, m0\n\ts_mov_b32 m0, %2\n\ts_nop 0\n\tglobal_load_lds_dwordx4 %1, off\n\ts_mov_b32 m0, %0" : "=&s"(keep) : "v"(gsrc), "s"(lds_dst) : "memory"); }
__device__ __forceinline__ s16x4 vtr(lds_cptr p) { typedef short v4i16_t __attribute__((ext_vector_type(4))); return __builtin_bit_cast(s16x4, __builtin_amdgcn_ds_read_tr16_b64_v4i16((__attribute__((address_space(3))) v4i16_t*)p)); }
__device__ __forceinline__ float swap32(float x) { const unsigned u = __float_as_uint(x); auto rr = __builtin_amdgcn_permlane32_swap(u, u, false, false); return __uint_as_float(rr[0] ^ rr[1] ^ u); }
__device__ __forceinline__ bf16x8 pack8(const f32x16& p, int b) { pg8::u32x4 w; w.x = pg8::cvt_pk_bf16(p[b], p[b + 1]); w.y = pg8::cvt_pk_bf16(p[b + 2], p[b + 3]); w.z = pg8::cvt_pk_bf16(p[b + 4], p[b + 5]); w.w = pg8::cvt_pk_bf16(p[b + 6], p[b + 7]); return __builtin_bit_cast(bf16x8, w); }
#define ATT_WAIT_BAR(N) asm volatile("s_waitcnt vmcnt(" #N ") lgkmcnt(0)\n\ts_barrier" ::: "memory")
__device__ __forceinline__ void pv(f32x16 (&o)[2], lds_cptr vp, const bf16x8 (&pa)[4]) {
#pragma unroll
    for (int d0 = 0; d0 < 2; ++d0)
#pragma unroll
        for (int ks = 0; ks < 4; ++ks) { const s16x4 lo = vtr(vp + d0 * 4096 + ks * 1024), hi = vtr(vp + d0 * 4096 + ks * 1024 + 512);
            const bf16x8 vb = (bf16x8){lo[0], lo[1], lo[2], lo[3], hi[0], hi[1], hi[2], hi[3]};
            o[d0] = __builtin_amdgcn_mfma_f32_32x32x16_bf16(pa[ks], vb, o[d0], 0, 0, 0); }
}
__device__ __forceinline__ void store_o(const f32x16 (&o)[2], const float (&rsc)[16], bf16* Ow, int pitch, float* POw, int pslot, LAS unsigned char* shm, int wid, int lane) {
    const int r32 = lane & 31, hi = lane >> 5;
    LAS bf16* stg = (LAS bf16*)(shm + LDS_OST + wid * 4096);
#pragma unroll
    for (int r = 0; r < 16; ++r) { const int orow = crow(r, hi);
#pragma unroll
        for (int d0 = 0; d0 < 2; ++d0) stg[orow * 64 + d0 * 32 + r32] = (bf16)f2bf(o[d0][r] * rsc[r]); }
    asm volatile("s_waitcnt lgkmcnt(0)" ::: "memory");
#pragma unroll
    for (int i = 0; i < 4; ++i) { const int row = i * 8 + (lane >> 3), ch = lane & 7; const v4u v = *(const LAS v4u*)(stg + row * 64 + ch * 8);
        *(GAS v4u*)(Ow + (size_t)row * pitch + ch * 8) = v;
        float s = 0.f;
#pragma unroll
        for (int j = 0; j < 4; ++j) { const float a = bflo(v[j]), b = bfhi(v[j]); s += a * a + b * b; }
        s += __shfl_xor(s, 1); s += __shfl_xor(s, 2); s += __shfl_xor(s, 4);
        if (ch == 0) POw[(size_t)row * 16 + pslot] = s; }
}

__device__ __forceinline__ void mla_unit(Frame& F, int b, int h, int qb, LAS unsigned char* shm) {
    const int wid = F.wave, lane = lane_id(), r32 = lane & 31, hi = lane >> 5;
    const long rowbase = (long)b * SEQ; const int q0 = qb * 256;
    const unsigned lds0 = (unsigned)(uintptr_t)shm;
    LAS float* wsf = (LAS float*)(shm + LDS_WS) + wid * 64;
    const bf16* ksrc = F.KN + (rowbase + lane) * 512 + h * 64 + wid * 8;
    const bf16* rsrc = F.Y1 + (rowbase + lane) * NINP + C_KR + (wid & 3) * 8;
    const bf16* vsrc = F.VM + (rowbase + 16 * (wid & 3) + (lane >> 2)) * 512 + h * 64 + (wid >> 2) * 32 + (lane & 3) * 8;
    const unsigned kdst = lds0 + LDS_K + wid * 1024, rdst = lds0 + LDS_K + (8 + (wid & 3)) * 1024, vdst = lds0 + LDS_V + wid * 1024;
#define MLA_DMA(t, sl) do { glds16(ksrc + (long)(t) * 64 * 512, (unsigned)__builtin_amdgcn_readfirstlane(kdst + (sl) * KSLOT)); glds16(rsrc + (long)(t) * 64 * NINP, (unsigned)__builtin_amdgcn_readfirstlane(rdst + (sl) * KSLOT)); \
        glds16(vsrc + (long)(t) * 64 * 512, (unsigned)__builtin_amdgcn_readfirstlane(vdst + (sl) * VSLOT)); } while (0)
    const int NT = 4 * qb + 4, tl = 4 * qb + (wid >> 1);
    MLA_DMA(0, 0); MLA_DMA(1, 1);
    const bf16* Qw = F.Q + (rowbase + q0 + wid * 32 + r32) * (HM * QKD) + h * QKD + hi * 8;
    bf16x8 qr[6];
#pragma unroll
    for (int d0 = 0; d0 < 6; ++d0) qr[d0] = *(const GAS bf16x8*)(Qw + d0 * 16);
    float m = -1e30f, l = 0.f; f32x16 o[2]; o[0] = f32x16{}; o[1] = f32x16{};
    const int qrel = (wid & 1) * 32 + r32;
    const lds_cptr shm3 = (lds_cptr)shm; const lds_cptr kp0 = shm3 + LDS_K + hi * 1024 + r32 * 16, vp0 = shm3 + LDS_V + ((lane >> 4) & 1) * 32 + (lane & 3) * 8 + (4 * hi + ((lane & 15) >> 2)) * 64;
    int sl = 0, sl2 = 2;
    for (int t = 0; t < NT; ++t) {
        if (t + 1 < NT) ATT_WAIT_BAR(3); else ATT_WAIT_BAR(0);
        if (t + 2 < NT) MLA_DMA(t + 2, sl2);
        if (t <= tl) {
            const lds_cptr kp = kp0 + sl * KSLOT;
            f32x16 p0 = f32x16{}, p1 = f32x16{};
#pragma unroll
            for (int d0 = 0; d0 < 6; ++d0) { const bf16x8 k0 = *(const __attribute__((address_space(3))) bf16x8*)(kp + d0 * 2048), k1 = *(const __attribute__((address_space(3))) bf16x8*)(kp + d0 * 2048 + 512);
                p0 = __builtin_amdgcn_mfma_f32_32x32x16_bf16(k0, qr[d0], p0, 0, 0, 0); p1 = __builtin_amdgcn_mfma_f32_32x32x16_bf16(k1, qr[d0], p1, 0, 0, 0); }
            if (t == tl) {
#pragma unroll
                for (int r = 0; r < 16; ++r) { const int kv = crow(r, hi); if (kv > qrel) p0[r] = -INFINITY; if (kv + 32 > qrel) p1[r] = -INFINITY; }
            }
            float rm = fmaxf(p0[0], p1[0]);
#pragma unroll
            for (int r = 1; r < 16; ++r) rm = fmaxf(rm, fmaxf(p0[r], p1[r]));
            rm = fmaxf(rm, swap32(rm));
            if (__any(rm > m + 8.0f)) {
                const float mn = fmaxf(m, rm), al = __builtin_amdgcn_exp2f(m - mn); m = mn; l *= al;
                if (hi == 0) wsf[r32] = al;
                asm volatile("s_waitcnt lgkmcnt(0)" ::: "memory");
#pragma unroll
                for (int r = 0; r < 16; ++r) { const float f = wsf[crow(r, hi)]; o[0][r] *= f; o[1][r] *= f; }
            }
            float ls = 0.f;
#pragma unroll
            for (int r = 0; r < 16; ++r) { p0[r] = __builtin_amdgcn_exp2f(p0[r] - m); p1[r] = __builtin_amdgcn_exp2f(p1[r] - m); ls += p0[r] + p1[r]; }
            l += ls;
            const bf16x8 pa[4] = {pack8(p0, 0), pack8(p0, 8), pack8(p1, 0), pack8(p1, 8)};
            pv(o, vp0 + sl * VSLOT, pa);
        }
        sl = (sl == 2) ? 0 : sl + 1; sl2 = (sl2 == 2) ? 0 : sl2 + 1;
    }
#undef MLA_DMA
    l += swap32(l);
    if (hi == 0) wsf[32 + r32] = l;
    asm volatile("s_waitcnt lgkmcnt(0)" ::: "memory");
    float rli[16];
#pragma unroll
    for (int r = 0; r < 16; ++r) rli[r] = __builtin_amdgcn_rcpf(wsf[32 + crow(r, hi)]);
    const long orow0 = rowbase + q0 + wid * 32;
    store_o(o, rli, F.O + orow0 * D + h * 64, D, F.PO + orow0 * 16, h, shm, wid, lane);
    asm volatile("s_waitcnt vmcnt(0) lgkmcnt(0)\n\ts_barrier" ::: "memory");
}

__device__ __forceinline__ void sb_unit(Frame& F, int b, int h, int qb, LAS unsigned char* shm) {
    const int wid = F.wave, lane = lane_id(), r32 = lane & 31, hi = lane >> 5;
    const long rowbase = (long)b * SEQ; const int q0 = qb * 256;
    const unsigned lds0 = (unsigned)(uintptr_t)shm;
    volatile LAS unsigned* flags = (volatile LAS unsigned*)(shm + LDS_FLAG);
    const bf16* ksrc = F.Y1 + (rowbase + lane) * NINP + C_KS + h * 64 + wid * 8;
    const bf16* vsrc = F.Y1 + (rowbase + 16 * (wid & 3) + (lane >> 2)) * NINP + C_VS + h * 64 + (wid >> 2) * 32 + (lane & 3) * 8;
    const unsigned kdst = lds0 + LDS_K + wid * 1024, vdst = lds0 + LDS_V + wid * 1024;
#define SB_DMA(t, sl) do { glds16(ksrc + (long)(t) * 64 * NINP, (unsigned)__builtin_amdgcn_readfirstlane(kdst + (sl) * KSLOT)); glds16(vsrc + (long)(t) * 64 * NINP, (unsigned)__builtin_amdgcn_readfirstlane(vdst + (sl) * VSLOT)); } while (0)
    const int NT = 4 * qb + 4, tl = 4 * qb + (wid >> 1);
    if (wid == 0 && lane < 3) flags[lane] = 0u;
    SB_DMA(NT - 1, 0); SB_DMA(NT - 2, 1);
    const bf16* Qw = F.Y1 + (rowbase + q0 + wid * 32 + r32) * NINP + C_QS + h * 64 + hi * 8;
    bf16x8 qr[4];
#pragma unroll
    for (int d0 = 0; d0 < 4; ++d0) qr[d0] = *(const GAS bf16x8*)(Qw + d0 * 16);
    float carry = 0.f; f32x16 o[2]; o[0] = f32x16{}; o[1] = f32x16{};
    const int qrel = (wid & 1) * 32 + r32;
    const lds_cptr shm3 = (lds_cptr)shm; const lds_cptr kp0 = shm3 + LDS_K + hi * 1024 + r32 * 16, vp0 = shm3 + LDS_V + ((lane >> 4) & 1) * 32 + (lane & 3) * 8 + (4 * hi + ((lane & 15) >> 2)) * 64;
    int sl = 0, sl2 = 2, f0 = 0;
    bool done = false;
    for (int i = 0; i < NT; ++i) {
        const int t = NT - 1 - i;
        if (i + 1 < NT) ATT_WAIT_BAR(2); else ATT_WAIT_BAR(0);
        if (i > 0) { const int fp = (f0 == 0) ? 2 : f0 - 1; if (flags[fp] == 0u) break; }
        { const int fn = (f0 == 2) ? 0 : f0 + 1; if (wid == 0 && lane == 0) flags[fn] = 0u; }
        if (i + 2 < NT) SB_DMA(t - 2, sl2);
        if (t <= tl && !done) {
            const lds_cptr kp = kp0 + sl * KSLOT;
            f32x16 z0 = f32x16{}, z1 = f32x16{};
#pragma unroll
            for (int d0 = 0; d0 < 4; ++d0) { const bf16x8 k0 = *(const __attribute__((address_space(3))) bf16x8*)(kp + d0 * 2048), k1 = *(const __attribute__((address_space(3))) bf16x8*)(kp + d0 * 2048 + 512);
                z0 = __builtin_amdgcn_mfma_f32_32x32x16_bf16(k0, qr[d0], z0, 0, 0, 0); z1 = __builtin_amdgcn_mfma_f32_32x32x16_bf16(k1, qr[d0], z1, 0, 0, 0); }
            f32x16 s0, s1;
#pragma unroll
            for (int r = 0; r < 16; ++r) { s0[r] = fmaxf(z0[r], 0.f) + __builtin_amdgcn_logf(1.0f + __builtin_amdgcn_exp2f(-fabsf(z0[r]))); s1[r] = fmaxf(z1[r], 0.f) + __builtin_amdgcn_logf(1.0f + __builtin_amdgcn_exp2f(-fabsf(z1[r]))); }
            const bool diag = (t == tl);
            if (diag) {
#pragma unroll
                for (int r = 0; r < 16; ++r) { const int kv = crow(r, hi); if (kv >= qrel) s0[r] = 0.f; if (kv + 32 >= qrel) s1[r] = 0.f; }
            }
            float own[8], part[8], R[8];
#pragma unroll
            for (int g = 0; g < 4; ++g) { own[g] = (s0[4 * g] + s0[4 * g + 1]) + (s0[4 * g + 2] + s0[4 * g + 3]); own[4 + g] = (s1[4 * g] + s1[4 * g + 1]) + (s1[4 * g + 2] + s1[4 * g + 3]); }
#pragma unroll
            for (int g = 0; g < 8; ++g) part[g] = swap32(own[g]);
            R[7] = 0.f;
#pragma unroll
            for (int g = 6; g >= 0; --g) R[g] = R[g + 1] + (own[g + 1] + part[g + 1]);
            const float total = R[0] + (own[0] + part[0]);
            f32x16 a0, a1;
#pragma unroll
            for (int g = 0; g < 4; ++g) {
                { const float base = carry - (R[g] + (hi == 0 ? part[g] : 0.f));
                  const float w3 = 0.f, w2 = s0[4 * g + 3], w1 = w2 + s0[4 * g + 2], w0 = w1 + s0[4 * g + 1];
                  a0[4 * g + 0] = __builtin_amdgcn_exp2f(z0[4 * g + 0] - s0[4 * g + 0] + (base - w0)); a0[4 * g + 1] = __builtin_amdgcn_exp2f(z0[4 * g + 1] - s0[4 * g + 1] + (base - w1));
                  a0[4 * g + 2] = __builtin_amdgcn_exp2f(z0[4 * g + 2] - s0[4 * g + 2] + (base - w2)); a0[4 * g + 3] = __builtin_amdgcn_exp2f(z0[4 * g + 3] - s0[4 * g + 3] + (base - w3)); }
                { const float base = carry - (R[4 + g] + (hi == 0 ? part[4 + g] : 0.f));
                  const float w3 = 0.f, w2 = s1[4 * g + 3], w1 = w2 + s1[4 * g + 2], w0 = w1 + s1[4 * g + 1];
                  a1[4 * g + 0] = __builtin_amdgcn_exp2f(z1[4 * g + 0] - s1[4 * g + 0] + (base - w0)); a1[4 * g + 1] = __builtin_amdgcn_exp2f(z1[4 * g + 1] - s1[4 * g + 1] + (base - w1));
                  a1[4 * g + 2] = __builtin_amdgcn_exp2f(z1[4 * g + 2] - s1[4 * g + 2] + (base - w2)); a1[4 * g + 3] = __builtin_amdgcn_exp2f(z1[4 * g + 3] - s1[4 * g + 3] + (base - w3)); }
            }
            if (diag) {
#pragma unroll
                for (int r = 0; r < 16; ++r) { const int kv = crow(r, hi); if (kv >= qrel) a0[r] = 0.f; if (kv + 32 >= qrel) a1[r] = 0.f; }
            }
            carry -= total;
            const bf16x8 pa[4] = {pack8(a0, 0), pack8(a0, 8), pack8(a1, 0), pack8(a1, 8)};
            pv(o, vp0 + sl * VSLOT, pa);
            done = __all(carry < SB_DONE);
        }
        if (!(t <= tl && done)) { if (lane == 0) flags[f0] = 1u; }
        sl = (sl == 2) ? 0 : sl + 1; sl2 = (sl2 == 2) ? 0 : sl2 + 1; f0 = (f0 == 2) ? 0 : f0 + 1;
    }
#undef SB_DMA
    float one[16];
#pragma unroll
    for (int r = 0; r < 16; ++r) one[r] = 1.0f;
    const long orow0 = rowbase + q0 + wid * 32;
    asm volatile("s_waitcnt vmcnt(0)" ::: "memory");
    store_o(o, one, F.O + orow0 * D + 512 + h * 64, D, F.PO + orow0 * 16, 8 + h, shm, wid, lane);
    asm volatile("s_waitcnt vmcnt(0) lgkmcnt(0)\n\ts_barrier" ::: "memory");
}
#undef ATT_WAIT_BAR
__device__ __forceinline__ void attn_phase(Frame& F, LAS unsigned char* shm) {
    const int bh = F.vcu >> 3, s = F.vcu & 7, b = bh >> 3, h = bh & 7;
    mla_unit(F, b, h, 15 - s, shm);
    mla_unit(F, b, h, s, shm);
    sb_unit(F, b, h, 15 - s, shm);
    sb_unit(F, b, h, s, shm);
}
}

enum { WK_IN = 0, WK_UQ, WK_UKV, WK_PLAIN, WK_GU };
__device__ __forceinline__ int p0_dst_row(int kind, int n) {
    if (kind == WK_IN) { if (n >= C_KR && n < C_QS) { const int i = n - C_KR; return C_KR + 2 * (i & 15) + (i >> 4); } return n; }
    if (kind == WK_UQ) { const int h = n / QKD, w = n % QKD; if (w >= NOPE) { const int i = w - NOPE; return h * QKD + NOPE + 2 * (i & 15) + (i >> 4); } return n; }
    if (kind == WK_UKV) { const int h = n >> 7, w = n & 127; return (w < 64) ? h * 64 + w : 512 + h * 64 + (w - 64); }
    if (kind == WK_GU) { const int nn = n & (DFF - 1); return (nn >> 7) * 256 + ((n >= DFF) ? 128 : 0) + (nn & 127); }
    return n;
}
template <bool FP8 = false> __device__ __forceinline__ void p0_transpose_item(const float* W, int ldw, int nsrc, bf16* WT, int ldt, int k0, int n0, int kind, const float* gk, float sc, float sc_qs, int lane) {
    const int q = lane >> 4, c = lane & 15, n = n0 + 4 * c;
    if (n >= nsrc) return;
    const GAS float* src = (const GAS float*)W + (size_t)(k0 + 16 * q) * ldw + n;
    f32x4 v[16];
#pragma unroll
    for (int j = 0; j < 16; ++j) v[j] = __builtin_nontemporal_load((const GAS f32x4*)(src + (size_t)j * ldw));
    f32x4 g[4];
#pragma unroll
    for (int j = 0; j < 4; ++j) g[j] = gk ? *(const GAS f32x4*)(gk + k0 + 16 * q + 4 * j) * sc : (f32x4){sc, sc, sc, sc};
    const float s2 = (kind == WK_IN && n >= C_QS && n < C_KS) ? sc_qs : 1.0f;
#pragma unroll
    for (int i = 0; i < 4; ++i) {
        const int nd = p0_dst_row(kind, n + i);
        v4u o0, o1;
#pragma unroll
        for (int jj = 0; jj < 4; ++jj) { o0[jj] = pk2(v[2 * jj][i] * g[(2 * jj) >> 2][(2 * jj) & 3] * s2, v[2 * jj + 1][i] * g[(2 * jj + 1) >> 2][(2 * jj + 1) & 3] * s2);
            o1[jj] = pk2(v[8 + 2 * jj][i] * g[(8 + 2 * jj) >> 2][(8 + 2 * jj) & 3] * s2, v[8 + 2 * jj + 1][i] * g[(8 + 2 * jj + 1) >> 2][(8 + 2 * jj + 1) & 3] * s2); }
        if constexpr (!FP8) { GAS v4u* dst = (GAS v4u*)(WT + (size_t)nd * ldt + k0 + 16 * q); dst[0] = o0; dst[1] = o1; }
        else { v4u o8;
#pragma unroll
            for (int jj = 0; jj < 4; ++jj) o8[jj] = pg8::pk4_fp8(v[4 * jj][i] * g[jj][0], v[4 * jj + 1][i] * g[jj][1], v[4 * jj + 2][i] * g[jj][2], v[4 * jj + 3][i] * g[jj][3]);
            *(GAS v4u*)((unsigned char*)WT + (size_t)nd * ldt + k0 + 16 * q) = o8; }
    }
}
__device__ __forceinline__ void p0_weights(Frame& F) {
    const int gw = F.vcu * NWAVES + F.wave, NGW = F.G * NWAVES, lane = F.lane;
    constexpr int NB_IN = (NIN + 63) / 64;
    constexpr int I_IN = (D / 64) * NB_IN, I_UQ = (QLR / 64) * (HM * QKD / 64), I_UKV = (KVLR / 64) * (HM * 128 / 64), I_O = (D / 64) * (D / 64), I_PG = I_O, I_PP = (PLE / 64) * (D / 64);
    constexpr int I_GU1 = (D / 64) * (2 * DFF / 64), I_DN1 = (DFF / 64) * (D / 64);
    constexpr int I_SMALL = I_IN + I_UQ + I_UKV + I_O + I_PG + I_PP, NITEMS = I_SMALL + NE * (I_GU1 + I_DN1);
    bf16* WIN = (bf16*)(F.ws + WS_WIN); bf16* WUQ = (bf16*)(F.ws + WS_WUQ); bf16* WUKV = (bf16*)(F.ws + WS_WUKV); bf16* WO = (bf16*)(F.ws + WS_WO); bf16* WPG = (bf16*)(F.ws + WS_WPG); bf16* WPP = (bf16*)(F.ws + WS_WPP);
    bf16* WGU = (bf16*)(F.ws + WS_WGU); bf16* WDN = (bf16*)(F.ws + WS_WDN);
    for (int it = gw; it < NITEMS; it += NGW) {
        int r = it;
        if (r < I_IN) { const int kb = r / NB_IN, n0 = 64 * (r % NB_IN); p0_transpose_item(F.w_in, NIN, NIN, WIN, D, 64 * kb, n0, WK_IN, F.g_attn, 1.0f, QS_SCALE, lane); continue; } r -= I_IN;
        if (r < I_UQ) { const int nb = HM * QKD / 64, kb = r / nb, n0 = 64 * (r % nb); p0_transpose_item(F.w_uq, HM * QKD, HM * QKD, WUQ, QLR, 64 * kb, n0, WK_UQ, F.g_cq, Q_SCALE, 1.0f, lane); continue; } r -= I_UQ;
        if (r < I_UKV) { const int nb = HM * 128 / 64, kb = r / nb, n0 = 64 * (r % nb); p0_transpose_item(F.w_ukv, HM * 128, HM * 128, WUKV, KVLR, 64 * kb, n0, WK_UKV, F.g_ckv, 1.0f, 1.0f, lane); continue; } r -= I_UKV;
        if (r < I_O) { const int nb = D / 64, kb = r / nb, n0 = 64 * (r % nb); const int k0 = 64 * kb;
            p0_transpose_item(F.w_o, D, D, WO, D, k0, n0, WK_PLAIN, (k0 < 512) ? F.g_out_mla : F.g_out_sb - 512, 1.0f, 1.0f, lane); continue; } r -= I_O;
        if (r < I_PG) { const int nb = D / 64, kb = r / nb, n0 = 64 * (r % nb); p0_transpose_item(F.w_ple_gate, D, D, WPG, D, 64 * kb, n0, WK_PLAIN, F.g_ple, 1.0f, 1.0f, lane); continue; } r -= I_PG;
        if (r < I_PP) { const int nb = D / 64, kb = r / nb, n0 = 64 * (r % nb); p0_transpose_item(F.w_ple_proj, D, D, WPP, PLE, 64 * kb, n0, WK_PLAIN, nullptr, 1.0f, 1.0f, lane); continue; } r -= I_PP;
        const int e = r / (I_GU1 + I_DN1); r -= e * (I_GU1 + I_DN1);
        if (r < I_GU1) { const int nb = 2 * DFF / 64, kb = r / nb, n0 = 64 * (r % nb);
#if MOE_FP8
            p0_transpose_item<true>(F.w_gu + (size_t)e * D * 2 * DFF, 2 * DFF, 2 * DFF, (bf16*)((unsigned char*)WGU + (size_t)e * 2 * DFF * D), D, 64 * kb, n0, WK_GU, F.g_moe, 32.0f, 1.0f, lane); continue; } r -= I_GU1;
#else
            p0_transpose_item(F.w_gu + (size_t)e * D * 2 * DFF, 2 * DFF, 2 * DFF, WGU + (size_t)e * 2 * DFF * D, D, 64 * kb, n0, WK_GU, F.g_moe, 1.0f, 1.0f, lane); continue; } r -= I_GU1;
#endif
        { const int nb = D / 64, kb = r / nb, n0 = 64 * (r % nb);
#if MOE_FP8
            p0_transpose_item<true>(F.w_dn + (size_t)e * DFF * D, D, D, (bf16*)((unsigned char*)WDN + (size_t)e * D * DFF), DFF, 64 * kb, n0, WK_PLAIN, nullptr, 32.0f, 1.0f, lane); }
#else
            p0_transpose_item(F.w_dn + (size_t)e * DFF * D, D, D, WDN + (size_t)e * D * DFF, DFF, 64 * kb, n0, WK_PLAIN, nullptr, 1.0f, 1.0f, lane); }
#endif
    }
    const int gt = blockIdx.x * NTHR + F.tid, NT = F.G * NTHR;
    for (int i = gt; i < (NINP - NIN) * D / 8; i += NT) ((GAS v4u*)(WIN + (size_t)NIN * D))[i] = (v4u){0u, 0u, 0u, 0u};
}

constexpr int N_PHASES = 13;
struct Args { const void* in[23]; float* out; unsigned char* ws; int ph_lo, ph_hi; };
__global__ void __launch_bounds__(NTHR, 2) mega_fwd(Args args) {
    extern __shared__ __attribute__((aligned(16))) unsigned char lds[];
    Frame F;
    F.lds = (LAS unsigned char*)lds;
    F.MISC = (volatile LAS unsigned*)(F.lds + MISC_OFF);
    F.tid = threadIdx.x; F.lane = F.tid & 63; F.wave = __builtin_amdgcn_readfirstlane(F.tid >> 6);
    F.G = gridDim.x; { const int bx = blockIdx.x; F.vcu = (F.G % 8 == 0) ? (bx % 8) * (F.G / 8) + bx / 8 : bx; }
    for (int u = F.tid; u < (LDS_BYTES - LDSCTL_OFF) / 4; u += NTHR) ((LAS unsigned*)(F.lds + LDSCTL_OFF))[u] = 0u;
    __syncthreads();
    if (F.tid == 0) { LAS unsigned long long* ap = (LAS unsigned long long*)(F.lds + L_ARGS);
#pragma unroll
        for (int i = 0; i < 23; ++i) ap[i] = (unsigned long long)args.in[i];
        ap[23] = (unsigned long long)args.out; ap[24] = (unsigned long long)args.ws; }
    __syncthreads();
    frame_refresh(F);
    const int lo = args.ph_lo, hi = args.ph_hi;
    const bool one = (hi - lo) > 1;
    XcdBarrier bar; bar.bar = (unsigned*)(F.ctl + CW_BAR); bar.x = 0; bar.st = nullptr;
    if (one) bar = xcd_barrier_post((unsigned*)(F.ctl + CW_BAR), F.MISC + 8);
#define IN(k) (frame_refresh(F), lo <= (k) && (k) < hi)
#define REP(k) _Pragma("unroll") for (int rep_ = 0; rep_ < ((((PROBE_DBL) >> (k)) & 1) ? 2 : 1); ++rep_)
#define SEAM(k) do { if (IN(k) && IN((k) + 1)) { xcd_barrier(bar, F.wave); _Pragma("unroll") for (int xb_ = 0; xb_ < PROBE_XBAR; ++xb_) xcd_barrier(bar, F.wave); } } while (0)
#define WIN ((bf16*)(F.ws + WS_WIN))
#define WUQ ((bf16*)(F.ws + WS_WUQ))
#define WUKV ((bf16*)(F.ws + WS_WUKV))
#define WO ((bf16*)(F.ws + WS_WO))
#define WPG ((bf16*)(F.ws + WS_WPG))
#define WPP ((bf16*)(F.ws + WS_WPP))
#define WGU ((bf16*)(F.ws + WS_WGU))
#define WDN ((bf16*)(F.ws + WS_WDN))
    LAS unsigned char* const ring = F.lds + RING_OFF;
    const volatile LAS int* const tsp = (const volatile LAS int*)(F.lds + L_TSTART);
    const int bid = (int)blockIdx.x;
    if (IN(0)) REP(0) { p0_prologue(F);
#if OPT_ROW
        r2_p0_rows(F); r2_p0_wrt(F);
#endif
#if OPT_P1 || OPT_P3 || OPT_P5 || OPT_P8 || OPT_P9 || OPT_P11
        p0_weights(F);
#endif
    } SEAM(0);
    if (IN(1)) REP(1) {
#if OPT_P1
        { pg8::Gemm g{F.XN, D, WIN, D, D}; pg8::StaticOrder S; S.init(T / 256, NINP / 256, F.G, bid); pg8::EpiInProj E{F.Y1, F.PA, F.COS, F.SIN};
          pg8::gemm_phase<pg8::EpiInProj, pg8::StaticOrder, true>(ring, F.wave, g, S, E); }
        { pg8::Gemm g{F.PBF, PLE, WPP, PLE, PLE}; pg8::StaticOrder S; S.init(T / 256, D / 256, F.G - 64, bid - 64); pg8::EpiStoreBf16 E{F.PROJ, D};
          pg8::gemm_phase<pg8::EpiStoreBf16, pg8::StaticOrder, true>(ring, F.wave, g, S, E); }
#else
        NE_InProj E{NIN}; naive_gemm(F, F.XN, D, T, E); NE_Proj E2{D}; naive_gemm(F, F.PBF, PLE, T, E2);
#endif
    } SEAM(1);
    if (IN(2)) {
#if !OPT_P1
        naive_rowssq(F);
#endif
    }
#if !OPT_P1
    SEAM(2);
#endif
    if (IN(3)) REP(3) {
#if OPT_P3
        { pg8::Gemm g{F.Y1 + C_CQ, NINP, WUQ, QLR, QLR}; pg8::StaticOrder S; S.init(T / 256, HM * QKD / 256, F.G, bid); pg8::EpiQ E{F.Q, F.PA, F.COS, F.SIN};
          pg8::gemm_phase<pg8::EpiQ, pg8::StaticOrder, false>(ring, F.wave, g, S, E); }
        { pg8::Gemm g{F.Y1 + C_CKV, NINP, WUKV, KVLR, KVLR}; pg8::StaticOrder S; S.init(T / 256, HM * 128 / 256, F.G, bid); pg8::EpiKV E{F.KN, F.VM, F.PA};
          pg8::gemm_phase<pg8::EpiKV, pg8::StaticOrder, false>(ring, F.wave, g, S, E); }
#else
        NE_Q E{HM * QKD}; naive_gemm(F, F.Y1 + C_CQ, NINP, T, E); NE_KV E2{HM * 128}; naive_gemm(F, F.Y1 + C_CKV, NINP, T, E2);
#endif
    } SEAM(3);
    if (IN(4)) REP(4) {
#if OPT_P4
        att::attn_phase(F, ring);
#else
        naive_attention(F);
#endif
    } SEAM(4);
    if (IN(5)) REP(5) {
#if OPT_P5
        pg8::Gemm g{F.O, D, WO, D, D}; pg8::StaticOrder S; S.init(T / 256, D / 256, F.G, bid); pg8::EpiWo E{F.x, F.H1, F.PO, (LAS float*)(F.lds + L_ROWS), (LAS float*)(F.lds + L_ROWS + 1024)};
        pg8::gemm_phase<pg8::EpiWo, pg8::StaticOrder, false>(ring, F.wave, g, S, E);
#else
        NE_Wo E{D}; naive_gemm(F, F.O, D, T, E);
#endif
    } SEAM(5);
#if OPT_ROW
    if (IN(6)) { if ((PROBE_DBL >> 6) & 1) r2_route<true>(F); r2_route<false>(F); } SEAM(6);
#if MOE_FP8
    if (IN(7)) REP(7) { r2_gather8(F); } SEAM(7);
#else
    if (IN(7)) REP(7) { r2_gather(F); } SEAM(7);
#endif
#else
    if (IN(6)) { p5a_route(F); } SEAM(6);
    if (IN(7)) { p5b_gather(F); } SEAM(7);
#endif
    if (IN(8)) REP(8) { if (!IN(7)) build_tstart(F);
#if OPT_P8
#if MOE_FP8
        pg8::Gemm g{F.XG, D, WGU, D, D}; pg8::GroupedOrder S; S.init(__builtin_amdgcn_readfirstlane(tsp[NE]), 2 * DFF / 256, F.G, bid); S.ts = tsp; pg8::EpiGu8 E{(unsigned char*)F.ACT, F.b_gu};
        pg8::gemm_phase<pg8::EpiGu8, pg8::GroupedOrder, true, 1>(ring, F.wave, g, S, E);
#else
        pg8::Gemm g{F.XG, D, WGU, D, D}; pg8::GroupedOrder S; S.init(__builtin_amdgcn_readfirstlane(tsp[NE]), 2 * DFF / 256, F.G, bid); S.ts = tsp; pg8::EpiGu E{F.ACT, F.b_gu};
        pg8::gemm_phase<pg8::EpiGu, pg8::GroupedOrder, true>(ring, F.wave, g, S, E);
#endif
#else
        NE_Gu E{DFF}; naive_gemm(F, F.XG, D, RPAD, E);
#endif
    } SEAM(8);
    if (IN(9)) REP(9) { if (!IN(7)) build_tstart(F);
#if OPT_P9
#if MOE_FP8
        pg8::Gemm g{F.ACT, DFF, WDN, DFF, DFF}; pg8::GroupedOrder S; S.init(__builtin_amdgcn_readfirstlane(tsp[NE]), D / 256, F.G, bid); S.ts = tsp; pg8::EpiDn8 E{F.Yb, F.b_dn};
        pg8::gemm_phase<pg8::EpiDn8, pg8::GroupedOrder, true, 1>(ring, F.wave, g, S, E);
#else
        pg8::Gemm g{F.ACT, DFF, WDN, DFF, DFF}; pg8::GroupedOrder S; S.init(__builtin_amdgcn_readfirstlane(tsp[NE]), D / 256, F.G, bid); S.ts = tsp; pg8::EpiDn E{F.Yb, F.b_dn};
        pg8::gemm_phase<pg8::EpiDn, pg8::GroupedOrder, true>(ring, F.wave, g, S, E);
#endif
#else
        NE_Dn E{D}; naive_gemm(F, F.ACT, DFF, RPAD, E);
#endif
    } SEAM(9);
#if OPT_ROW
    if (IN(10)) { if ((PROBE_DBL >> 10) & 1) r2_combine<true>(F); r2_combine<false>(F); } SEAM(10);
#else
    if (IN(10)) { p8_combine(F); } SEAM(10);
#endif
    if (IN(11)) REP(11) {
#if OPT_P11
        pg8::Gemm g{F.XN, D, WPG, D, D}; pg8::StaticOrder S; S.init(T / 256, D / 256, F.G, bid); pg8::EpiGate E{F.H1, F.PROJ, F.out};
        pg8::gemm_phase<pg8::EpiGate, pg8::StaticOrder, false>(ring, F.wave, g, S, E);
#else
        NE_Gate E{D}; naive_gemm(F, F.XN, D, T, E);
#endif
    } SEAM(11);
#if OPT_ROW
    if (IN(12)) { if ((PROBE_DBL >> 12) & 1) r2_final<true>(F); r2_final<false>(F); }
#else
    if (IN(12)) { p10_final(F); }
#endif
#undef IN
#undef SEAM
}

extern "C" void kernel_launch(void* const* d_in, const int* in_sizes, int n_in, void* d_out, int out_size, void* d_ws, size_t ws_size, hipStream_t stream) {
    static int grid = 0;
    if (grid == 0) {
        if (n_in != 23 || in_sizes[0] != T * D || out_size != T * D || ws_size < WS_END) { fprintf(stderr, "kernel_launch: unexpected shapes (n_in %d, in0 %d, out %d, ws %zu); nothing launched\n", n_in, n_in > 0 ? in_sizes[0] : -1, out_size, ws_size); grid = -1; return; }
        int dev = 0, cus = 0;
        if (hipGetDevice(&dev) != hipSuccess || hipDeviceGetAttribute(&cus, hipDeviceAttributeMultiprocessorCount, dev) != hipSuccess) { grid = -1; return; }
        if (hipFuncSetAttribute((const void*)mega_fwd, hipFuncAttributeMaxDynamicSharedMemorySize, LDS_BYTES) != hipSuccess) { fprintf(stderr, "kernel_launch: hipFuncSetAttribute failed\n"); grid = -1; return; }
        int per_cu = 0;
        if (hipOccupancyMaxActiveBlocksPerMultiprocessor(&per_cu, (const void*)mega_fwd, NTHR, LDS_BYTES) != hipSuccess || per_cu < 1) fprintf(stderr, "kernel_launch: occupancy query reports %d\n", per_cu);
        (void)hipGetLastError();
        grid = cus;
        if (grid != 256) fprintf(stderr, "kernel_launch: %d CUs (expected 256)\n", grid);
    }
    if (grid < 0) return;
    (void)hipMemsetAsync((char*)d_ws + WS_CTL, 0, CTL_ZERO_BYTES, stream);
    Args a{};
    for (int i = 0; i < 23; ++i) a.in[i] = d_in[i];
    a.out = (float*)d_out; a.ws = (unsigned char*)d_ws;
#if MK_ONE_LAUNCH
    a.ph_lo = 0; a.ph_hi = N_PHASES;
    hipLaunchKernelGGL(mega_fwd, dim3(grid), dim3(NTHR), LDS_BYTES, stream, a);
#else
    for (int ph = 0; ph < N_PHASES; ++ph) { a.ph_lo = ph; a.ph_hi = ph + 1; hipLaunchKernelGGL(mega_fwd, dim3(grid), dim3(NTHR), LDS_BYTES, stream, a); }
#endif
}
```
